# Optimizing an MI355X kernel written in HIP

```python
import numpy as np
import jax, jax.numpy as jnp
from jax import lax

D_MODEL = 1024
BATCH = 8
SEQ = 2048
DEPTH = 2

GRID_W = 64
CTX_LEN = 256
N_MIXERS = 2
N_HEADS = 16
HEAD_DIM = D_MODEL // N_HEADS
NA_KH = 8
NA_KW = 16
NA_QCB = NA_KW
NA_KCB = 2 * NA_KW
WA_KV_HEADS = 4
WA_GROUPS = N_HEADS // WA_KV_HEADS
WA_WINDOW = 128
WA_BLOCK = 128
D_FF = 2816
FFN_RES = 0.5
ROPE_BASE = 10000.0
N_MOD = 9
ALPHA = (2 * DEPTH) ** 0.25
BETA = (8 * DEPTH) ** -0.25
LN_EPS = 1e-5
NEG_INF = -1e30
N_NA_LAYERS = (DEPTH + 1) // 2
N_WA_LAYERS = DEPTH // 2

kernel_name = "hybrid_natten_swa_macaron_deepnorm"


def layer_norm(x, g, b):
    xf = x.astype(jnp.float32)
    mu = jnp.mean(xf, axis=-1, keepdims=True)
    var = jnp.mean(jnp.square(xf - mu), axis=-1, keepdims=True)
    return ((xf - mu) * lax.rsqrt(var + LN_EPS)).astype(x.dtype) * g + b


def modulate(h, shift, scale):
    return h * (1.0 + scale) + shift


def swiglu(u, w_in, w_out):
    a, v = jnp.split(u @ w_in, 2, axis=-1)
    return (jax.nn.silu(a) * v) @ w_out


def ffn_sublayer(h, shift, scale, gate, w_in, w_out, g, b):
    y = swiglu(modulate(h, shift, scale), w_in, w_out)
    return layer_norm(ALPHA * h + FFN_RES * gate * y, g, b)


def axial_rope(x):
    S = x.shape[1]
    t = jnp.arange(S, dtype=jnp.int32)
    rows = (t // GRID_W).astype(jnp.float32)
    cols = (t % GRID_W).astype(jnp.float32)
    n = HEAD_DIM // 4
    inv_freq = ROPE_BASE ** (-jnp.arange(n, dtype=jnp.float32) / n)
    half = HEAD_DIM // 2

    def rot(xa, pos):
        ang = pos[:, None] * inv_freq[None, :]
        cos = jnp.cos(ang)[None, :, None, :].astype(x.dtype)
        sin = jnp.sin(ang)[None, :, None, :].astype(x.dtype)
        x1, x2 = xa[..., :n], xa[..., n:]
        return jnp.concatenate([x1 * cos - x2 * sin, x2 * cos + x1 * sin], axis=-1)

    return jnp.concatenate([rot(x[..., :half], rows), rot(x[..., half:], cols)], axis=-1)


def ctx_attention(qc, kc, vc, sink):
    B, C, H, d = qc.shape
    hk = kc.shape[2]
    g = H // hk
    qg = qc.reshape(B, C, hk, g, d)
    s = jnp.einsum('bqhgd,bkhd->bhgqk', qg, kc).astype(jnp.float32)
    if sink is not None:
        sk = jnp.broadcast_to(sink.astype(jnp.float32).reshape(1, hk, g, 1, 1), s.shape[:-1] + (1,))
        s = jnp.concatenate([s, sk], axis=-1)
    p = jax.nn.softmax(s, axis=-1)[..., :C].astype(vc.dtype)
    o = jnp.einsum('bhgqk,bkhd->bqhgd', p, vc)
    return o.reshape(B, C, H * d)


def neighborhood_attention(u_lat, u_ctx, w_qkv, w_o, rpb, with_ctx_out):
    B, S, _ = u_lat.shape
    C = u_ctx.shape[1]
    rows = S // GRID_W
    kh = min(NA_KH, rows)
    scale = HEAD_DIM ** -0.5
    qkv = (u_lat @ w_qkv).reshape(B, rows, GRID_W, 3, N_HEADS, HEAD_DIM)
    q = qkv[:, :, :, 0] * scale
    k = qkv[:, :, :, 1]
    v = qkv[:, :, :, 2]
    kvc = (u_ctx @ w_qkv[:, D_MODEL:]).reshape(B, C, 2, N_HEADS, HEAD_DIM)
    kc, vc = kvc[:, :, 0], kvc[:, :, 1]

    ncb = GRID_W // NA_QCB
    qcol = np.arange(GRID_W).reshape(ncb, NA_QCB)
    blk_start = np.clip(np.arange(ncb) * NA_QCB - NA_KW // 2, 0, GRID_W - NA_KCB)
    kcol = blk_start[:, None] + np.arange(NA_KCB)[None, :]
    win_start = np.clip(qcol - NA_KW // 2, 0, GRID_W - NA_KW)
    col_valid = (kcol[:, None, :] >= win_start[..., None]) & (kcol[:, None, :] < win_start[..., None] + NA_KW)
    col_off = np.clip(kcol[:, None, :] - qcol[..., None], -(NA_KW - 1), NA_KW - 1) + NA_KW - 1
    bias_cols = jnp.where(col_valid, rpb[:, :, col_off].astype(jnp.float32), NEG_INF)
    n_win = kh * NA_KCB

    def row_block(r):
        rs = jnp.clip(r - kh // 2, 0, rows - kh)
        q_r = lax.dynamic_index_in_dim(q, r, axis=1, keepdims=False).reshape(B, ncb, NA_QCB, N_HEADS, HEAD_DIM)
        k_r = lax.dynamic_slice_in_dim(k, rs, kh, axis=1)[:, :, kcol]
        v_r = lax.dynamic_slice_in_dim(v, rs, kh, axis=1)[:, :, kcol]
        row_idx = rs + jnp.arange(kh) - r + NA_KH - 1
        bias = jnp.take(bias_cols, row_idx, axis=1).transpose(0, 2, 3, 1, 4)[None]
        s_win = jnp.einsum('bcqhd,bicjhd->bhcqij', q_r, k_r).astype(jnp.float32) + bias
        s_win = s_win.reshape(B, N_HEADS, ncb, NA_QCB, n_win)
        s_ctx = jnp.einsum('bcqhd,bkhd->bhcqk', q_r, kc).astype(jnp.float32)
        p = jax.nn.softmax(jnp.concatenate([s_win, s_ctx], axis=-1), axis=-1).astype(v.dtype)
        p_win = p[..., :n_win].reshape(B, N_HEADS, ncb, NA_QCB, kh, NA_KCB)
        p_ctx = p[..., n_win:]
        o = (jnp.einsum('bhcqij,bicjhd->bcqhd', p_win, v_r)
             + jnp.einsum('bhcqk,bkhd->bcqhd', p_ctx, vc))
        return o.reshape(B, GRID_W, D_MODEL)

    out = lax.map(row_block, jnp.arange(rows, dtype=jnp.int32))
    y_lat = out.transpose(1, 0, 2, 3).reshape(B, S, D_MODEL) @ w_o
    y_ctx = None
    if with_ctx_out:
        qc = (u_ctx @ w_qkv[:, :D_MODEL]).reshape(B, C, N_HEADS, HEAD_DIM) * scale
        y_ctx = ctx_attention(qc, kc, vc, None) @ w_o
    return y_lat, y_ctx


def window_gqa(u_lat, u_ctx, w_qkv, w_o, sinks, with_ctx_out):
    B, S, _ = u_lat.shape
    C = u_ctx.shape[1]
    dq = N_HEADS * HEAD_DIM
    dkv = WA_KV_HEADS * HEAD_DIM
    scale = HEAD_DIM ** -0.5
    qkv = u_lat @ w_qkv
    q = axial_rope(qkv[..., :dq].reshape(B, S, N_HEADS, HEAD_DIM)) * scale
    k = axial_rope(qkv[..., dq:dq + dkv].reshape(B, S, WA_KV_HEADS, HEAD_DIM))
    v = qkv[..., dq + dkv:].reshape(B, S, WA_KV_HEADS, HEAD_DIM)
    kvc = u_ctx @ w_qkv[:, dq:]
    kc = kvc[..., :dkv].reshape(B, C, WA_KV_HEADS, HEAD_DIM)
    vc = kvc[..., dkv:].reshape(B, C, WA_KV_HEADS, HEAD_DIM)

    nb = S // WA_BLOCK
    pad = ((0, 0), (WA_BLOCK, WA_BLOCK), (0, 0), (0, 0))
    k_pad = jnp.pad(k, pad)
    v_pad = jnp.pad(v, pad)
    q_blk = q.reshape(B, nb, WA_BLOCK, WA_KV_HEADS, WA_GROUPS, HEAD_DIM)
    sink = sinks.astype(jnp.float32).reshape(1, WA_KV_HEADS, WA_GROUPS, 1, 1)
    qi = jnp.arange(WA_BLOCK, dtype=jnp.int32)
    kj = jnp.arange(3 * WA_BLOCK, dtype=jnp.int32)
    n_win = 3 * WA_BLOCK

    def band_block(b):
        qb = lax.dynamic_index_in_dim(q_blk, b, axis=1, keepdims=False)
        kb = lax.dynamic_slice_in_dim(k_pad, b * WA_BLOCK, n_win, axis=1)
        vb = lax.dynamic_slice_in_dim(v_pad, b * WA_BLOCK, n_win, axis=1)
        pos_q = b * WA_BLOCK + qi
        pos_k = (b - 1) * WA_BLOCK + kj
        valid = ((jnp.abs(pos_q[:, None] - pos_k[None, :]) <= WA_WINDOW)
                 & (pos_k >= 0)[None, :] & (pos_k < S)[None, :])
        s_win = jnp.where(valid, jnp.einsum('bqhgd,bkhd->bhgqk', qb, kb).astype(jnp.float32), NEG_INF)
        s_ctx = jnp.einsum('bqhgd,bkhd->bhgqk', qb, kc).astype(jnp.float32)
        s_sink = jnp.broadcast_to(sink, s_win.shape[:-1] + (1,))
        p = jax.nn.softmax(jnp.concatenate([s_win, s_ctx, s_sink], axis=-1), axis=-1).astype(v.dtype)
        o = (jnp.einsum('bhgqk,bkhd->bqhgd', p[..., :n_win], vb)
             + jnp.einsum('bhgqk,bkhd->bqhgd', p[..., n_win:n_win + C], vc))
        return o.reshape(B, WA_BLOCK, D_MODEL)

    out = lax.map(band_block, jnp.arange(nb, dtype=jnp.int32))
    y_lat = out.transpose(1, 0, 2, 3).reshape(B, S, D_MODEL) @ w_o
    y_ctx = None
    if with_ctx_out:
        qc = (u_ctx @ w_qkv[:, :dq]).reshape(B, C, N_HEADS, HEAD_DIM) * scale
        y_ctx = ctx_attention(qc, kc, vc, sinks) @ w_o
    return y_lat, y_ctx


def setup_inputs(seed: int = 0) -> dict:
    key = jax.random.key(seed)
    ks = jax.random.split(key, 16)
    f32 = jnp.float32
    dq = N_HEADS * HEAD_DIM
    dkv = WA_KV_HEADS * HEAD_DIM

    def nrm(k, shape, s):
        return jax.random.normal(k, shape, f32) * s

    return {
        "x": nrm(ks[0], (BATCH, SEQ, D_MODEL), 1.0),
        "c": nrm(ks[1], (BATCH, D_MODEL), 1.0),
        "ctx": nrm(ks[2], (BATCH, CTX_LEN, D_MODEL), 1.0),
        "c_ctx": nrm(ks[3], (D_MODEL,), 1.0),
        "w_mod": nrm(ks[4], (DEPTH, D_MODEL, N_MOD * D_MODEL), 0.5 * D_MODEL ** -0.5),
        "b_mod": nrm(ks[5], (DEPTH, N_MOD * D_MODEL), 0.02),
        "ln_g": 1.0 + nrm(ks[6], (DEPTH, 3, D_MODEL), 0.02),
        "ln_b": nrm(ks[7], (DEPTH, 3, D_MODEL), 0.02),
        "ffn_w_in": nrm(ks[8], (DEPTH, 2, D_MODEL, 2 * D_FF), D_MODEL ** -0.5),
        "ffn_w_out": nrm(ks[9], (DEPTH, 2, D_FF, D_MODEL), BETA * D_FF ** -0.5),
        "na_w_qkv": nrm(ks[10], (N_NA_LAYERS, D_MODEL, 3 * dq), D_MODEL ** -0.5),
        "na_w_o": nrm(ks[11], (N_NA_LAYERS, dq, D_MODEL), BETA * dq ** -0.5),
        "na_rpb": nrm(ks[12], (N_NA_LAYERS, N_HEADS, 2 * NA_KH - 1, 2 * NA_KW - 1), 0.1),
        "wa_w_qkv": nrm(ks[13], (N_WA_LAYERS, D_MODEL, dq + 2 * dkv), D_MODEL ** -0.5),
        "wa_w_o": nrm(ks[14], (N_WA_LAYERS, dq, D_MODEL), BETA * dq ** -0.5),
        "wa_sinks": nrm(ks[15], (N_WA_LAYERS, N_HEADS), 0.5),
    }


def reference(x, c, ctx, c_ctx, w_mod, b_mod, ln_g, ln_b, ffn_w_in, ffn_w_out,
              na_w_qkv, na_w_o, na_rpb, wa_w_qkv, wa_w_o, wa_sinks):
    h_lat, h_ctx = x, ctx
    silu_c = jax.nn.silu(c)
    silu_cc = jax.nn.silu(c_ctx)
    for i in range(DEPTH):
        ctx_needed = i < DEPTH - 1
        m_lat = jnp.split((silu_c @ w_mod[i] + b_mod[i])[:, None, :], N_MOD, axis=-1)
        m_ctx = jnp.split((silu_cc @ w_mod[i] + b_mod[i])[None, None, :], N_MOD, axis=-1)

        h_lat = ffn_sublayer(h_lat, m_lat[0], m_lat[1], m_lat[2], ffn_w_in[i, 0], ffn_w_out[i, 0], ln_g[i, 0], ln_b[i, 0])
        h_ctx = ffn_sublayer(h_ctx, m_ctx[0], m_ctx[1], m_ctx[2], ffn_w_in[i, 0], ffn_w_out[i, 0], ln_g[i, 0], ln_b[i, 0])

        u_lat = modulate(h_lat, m_lat[3], m_lat[4])
        u_ctx = modulate(h_ctx, m_ctx[3], m_ctx[4])
        j = i // N_MIXERS
        if i % N_MIXERS == 0:
            y_lat, y_ctx = neighborhood_attention(u_lat, u_ctx, na_w_qkv[j], na_w_o[j], na_rpb[j], ctx_needed)
        else:
            y_lat, y_ctx = window_gqa(u_lat, u_ctx, wa_w_qkv[j], wa_w_o[j], wa_sinks[j], ctx_needed)
        h_lat = layer_norm(ALPHA * h_lat + m_lat[5] * y_lat, ln_g[i, 1], ln_b[i, 1])

        h_lat = ffn_sublayer(h_lat, m_lat[6], m_lat[7], m_lat[8], ffn_w_in[i, 1], ffn_w_out[i, 1], ln_g[i, 2], ln_b[i, 2])
        if ctx_needed:
            h_ctx = layer_norm(ALPHA * h_ctx + m_ctx[5] * y_ctx, ln_g[i, 1], ln_b[i, 1])
            h_ctx = ffn_sublayer(h_ctx, m_ctx[6], m_ctx[7], m_ctx[8], ffn_w_in[i, 1], ffn_w_out[i, 1], ln_g[i, 2], ln_b[i, 2])
    return h_lat
```

```cpp
#include <hip/hip_runtime.h>
#include <hip/hip_cooperative_groups.h>
#include <cstdio>
#include <cstdint>
namespace cg = cooperative_groups;
namespace pg8 {
#define PG8_LAS __attribute__((address_space(3)))
typedef unsigned short bf16_t;
typedef short bf16x8 __attribute__((ext_vector_type(8)));
typedef float f32x4 __attribute__((ext_vector_type(4)));
typedef unsigned u32x4 __attribute__((ext_vector_type(4)));
constexpr int BM = 256, BK = 64, HALF = 128, HTB = HALF * BK * 2  , STAGE_BYTES = 8 * HTB, NXCD = 8, WGM = 8;

__host__ __device__ __forceinline__ int lds_byte(int r, int c) { const int st = (r >> 4) * 2 + (c >> 5), rr = r & 15, cc = c & 31, ob = rr * 64 + cc * 2; return st * 1024 + (ob ^ (((ob >> 9) & 1) << 5)); }
__host__ __device__ __forceinline__ void stage_rc(int b, int& R, int& C) { const int st = b / 1024, sb = b % 1024, swz = sb ^ (((sb >> 9) & 1) << 5); R = (st >> 1) * 16 + swz / 64; C = (st & 1) * 32 + (swz % 64) / 2; }
__host__ __device__ __forceinline__ int perm32(int rho) { const int n = rho >> 4, i = rho & 15; return 8 * (i >> 2) + 4 * n + (i & 3); }

struct Unit { int pm, pn; };
struct Gemm { const bf16_t* A; const bf16_t* Bt; int M, N, K; };

struct StaticOrder {
    int nM, nN, nwg, G, c;
    __host__ __device__ void init(int M, int N, int G_, int c_) { nM = M / BM; nN = N / BM; nwg = nM * nN; G = G_; c = c_; }
    __host__ __device__ bool next(int i, Unit& u) const {
        const long L = (long)i * G + c; if (L >= nwg) return false;
        int wgid = (int)L; { const int q = nwg / NXCD, r = nwg % NXCD, xcd = wgid % NXCD, off = wgid / NXCD; wgid = (xcd < r ? xcd * (q + 1) : r * (q + 1) + (xcd - r) * q) + off; }
        const int nig = WGM * nN, gid = wgid / nig, fm = gid * WGM, gsz = (nM - fm) < WGM ? (nM - fm) : WGM;
        u.pm = fm + ((wgid % nig) % gsz); u.pn = (wgid % nig) / gsz; return true;
    }
    __device__ __forceinline__ void a_ready(const Unit&) const {}
    __device__ __forceinline__ void done(const Unit&) const {}
};

__device__ __forceinline__ unsigned cvt_pk_bf16(float lo, float hi) { unsigned r; asm volatile("v_cvt_pk_bf16_f32 %0, %1, %2" : "=v"(r) : "v"(lo), "v"(hi)); return r; }
typedef float f32x2 __attribute__((ext_vector_type(2)));
typedef unsigned u32x4 __attribute__((ext_vector_type(4)));
struct EpiSwiGLU {
    static constexpr bool PERM = true, AFTER_DRAIN = false;
    bf16_t* O; int ldc;
    __device__ __forceinline__ void operator()(const f32x4 (&acc)[2][2][4][2], const Unit& u, int wr, int wc, int fr, int fq) const {
        const int row0 = u.pm * BM + wr * 64 + fr, col0 = u.pn * HALF + wc * 32 + 8 * fq;
#pragma unroll
        for (int ai = 0; ai < 2; ++ai)
#pragma unroll
            for (int m = 0; m < 4; ++m) {
                bf16_t* rowp = O + (size_t)(row0 + ai * HALF + m * 16) * ldc + col0;
                float h[8];
#pragma unroll
                for (int n = 0; n < 2; ++n)
#pragma unroll
                    for (int e = 0; e < 4; ++e) { const float a = acc[ai][0][m][n][e], v = acc[ai][1][m][n][e];
                        const float sg = __builtin_amdgcn_rcpf(1.0f + __builtin_amdgcn_exp2f(-1.4426950408889634f * a)); h[4 * n + e] = a * sg * v; }
                u32x4 w; w.x = cvt_pk_bf16(h[0], h[1]); w.y = cvt_pk_bf16(h[2], h[3]); w.z = cvt_pk_bf16(h[4], h[5]); w.w = cvt_pk_bf16(h[6], h[7]);
                *(u32x4*)rowp = w; }
    }
};
struct EpiRes {
    static constexpr bool PERM = false, AFTER_DRAIN = false;
    const float* res_lat; const float* res_ctx; float* out; const float* gate; float w; float alpha;
    __device__ __forceinline__ void operator()(const f32x4 (&acc)[2][2][4][2], const Unit& u, int wr, int wc, int fr, int fq) const {
        const int mi = u.pm < 64 ? (u.pm >> 3) : 8;
        const float* g = gate + (size_t)mi * 9216;
        const int col0 = u.pn * BM + wc * 32 + 4 * fq;
        f32x4 gv[2][2];
#pragma unroll
        for (int bj = 0; bj < 2; ++bj)
#pragma unroll
            for (int n = 0; n < 2; ++n) gv[bj][n] = *(const f32x4*)(g + col0 + bj * HALF + n * 16) * w;
        const float* rbase = u.pm < 64 ? res_lat + (size_t)(u.pm * BM) * 1024 : res_ctx + (size_t)(u.pm * BM - 16384) * 1024;
        float* obase = out + (size_t)(u.pm * BM) * 1024;
#pragma unroll
        for (int ai = 0; ai < 2; ++ai)
#pragma unroll
            for (int m = 0; m < 4; ++m) { const size_t off = (size_t)(ai * HALF + wr * 64 + m * 16 + fr) * 1024 + col0;
                f32x4 r[2][2];
#pragma unroll
                for (int bj = 0; bj < 2; ++bj)
#pragma unroll
                    for (int n = 0; n < 2; ++n) r[bj][n] = *(const f32x4*)(rbase + off + bj * HALF + n * 16);
#pragma unroll
                for (int bj = 0; bj < 2; ++bj)
#pragma unroll
                    for (int n = 0; n < 2; ++n) *(f32x4*)(obase + off + bj * HALF + n * 16) = r[bj][n] * alpha + gv[bj][n] * acc[ai][bj][m][n];
                asm volatile("" ::: "memory"); }
    }
};
struct EpiQKV {
    static constexpr bool PERM = true, AFTER_DRAIN = false;
    bf16_t* O; int ldc; float qscale; int ropecols; const float* ropetab;
    __device__ __forceinline__ void operator()(const f32x4 (&acc)[2][2][4][2], const Unit& u, int wr, int wc, int fr, int fq) const {
        const int row0 = u.pm * BM + wr * 64 + fr;
#pragma unroll
        for (int bj = 0; bj < 2; ++bj) {
            const int ct = u.pn * BM + bj * HALF + wc * 32, col0 = ct + 8 * fq;
            const float sc = ct < 1024 ? qscale : 1.0f;
            const bool dorope = (ct < ropecols) && (u.pm < 64);
            const float sgn = fq >= 2 ? 1.0f : -1.0f;
#pragma unroll
            for (int ai = 0; ai < 2; ++ai)
#pragma unroll
                for (int m = 0; m < 4; ++m) {
                    const int row = row0 + ai * HALF + m * 16;
                    f32x4 v0 = acc[ai][bj][m][0], v1 = acc[ai][bj][m][1];
                    if (dorope) {
                        f32x4 p0, p1;
#pragma unroll
                        for (int e = 0; e < 4; ++e) { p0[e] = __shfl_xor(v0[e], 32); p1[e] = __shfl_xor(v1[e], 32); }
                        const int t = row & 2047, pos = (wc & 1) ? (t & 63) : (t >> 6);
                        const f32x4* tp = (const f32x4*)(ropetab + (size_t)(pos * 16 + 8 * (fq & 1)) * 2);
                        const f32x4 c0 = tp[0], c1 = tp[1], c2 = tp[2], c3 = tp[3];
                        v0[0] = v0[0] * c0[0] + sgn * p0[0] * c0[1]; v0[1] = v0[1] * c0[2] + sgn * p0[1] * c0[3];
                        v0[2] = v0[2] * c1[0] + sgn * p0[2] * c1[1]; v0[3] = v0[3] * c1[2] + sgn * p0[3] * c1[3];
                        v1[0] = v1[0] * c2[0] + sgn * p1[0] * c2[1]; v1[1] = v1[1] * c2[2] + sgn * p1[1] * c2[3];
                        v1[2] = v1[2] * c3[0] + sgn * p1[2] * c3[1]; v1[3] = v1[3] * c3[2] + sgn * p1[3] * c3[3];
                    }
                    v0 = v0 * sc; v1 = v1 * sc;
                    u32x4 w; w.x = cvt_pk_bf16(v0[0], v0[1]); w.y = cvt_pk_bf16(v0[2], v0[3]); w.z = cvt_pk_bf16(v1[0], v1[1]); w.w = cvt_pk_bf16(v1[2], v1[3]);
                    *(u32x4*)(O + (size_t)row * ldc + col0) = w; }
        }
    }
};
template <class Epi, class Sched, bool ALIGN_EPI = false, bool SP2 = false>
__device__ __forceinline__ void gemm_phase(PG8_LAS unsigned char* lds, const Gemm g, const Sched& S, const Epi& E) {
    int tid_ = threadIdx.x; asm volatile("" : "+v"(tid_)); const int tid = tid_, wid = __builtin_amdgcn_readfirstlane(tid >> 6), lane = tid & 63, wr = wid >> 2, wc = wid & 3, fr = lane & 15, fq = lane >> 4;
    const int K = g.K, nt = K / BK;
    unsigned voffA[2], voffB[2];
#pragma unroll
    for (int i = 0; i < 2; ++i) { int R, C; stage_rc(tid * 16 + i * 8192, R, C); const int Rb = Epi::PERM ? ((R & ~31) + perm32(R & 31)) : R;
        voffA[i] = (unsigned)(R * K + C) * 2u; voffB[i] = (unsigned)(Rb * K + C) * 2u; }
    const size_t kstep = (size_t)(BK * 2);
    const size_t hstep = (size_t)HALF * K * 2;
    const size_t tstep = 2 * hstep;
    const unsigned ldsw = (unsigned)wid * 1024u;
    const int aoff = lds_byte(wr * 64 + fr, fq * 8), boff = lds_byte(wc * 32 + fr, fq * 8);
#define PG8_SA(b, h) (((b) * 2 + (h)) * HTB)
#define PG8_SB(b, h) ((4 + (b) * 2 + (h)) * HTB)
#define PG8_STAGE(bufoff, gbase, voff) do { _Pragma("unroll") for (int _i = 0; _i < 2; ++_i) \
        __builtin_amdgcn_global_load_lds((const unsigned*)((const char*)(gbase) + (voff)[_i]), (PG8_LAS unsigned*)(lds + (bufoff) + ldsw + _i * 8192), 16, 0, 0); } while (0)
#define PG8_LDA(dst, b, h) do { _Pragma("unroll") for (int m = 0; m < 4; ++m) _Pragma("unroll") for (int k = 0; k < 2; ++k) dst[m][k] = *(const PG8_LAS bf16x8*)(lds + PG8_SA(b, h) + aoff + m * 2048 + k * 1024); } while (0)
#define PG8_LDB(dst, b, h) do { _Pragma("unroll") for (int n = 0; n < 2; ++n) _Pragma("unroll") for (int k = 0; k < 2; ++k) dst[n][k] = *(const PG8_LAS bf16x8*)(lds + PG8_SB(b, h) + boff + n * 2048 + k * 1024); } while (0)
#define PG8_MMA(ai, bj, At, Bt) do { __builtin_amdgcn_s_setprio(1); _Pragma("unroll") for (int m = 0; m < 4; ++m) _Pragma("unroll") for (int n = 0; n < 2; ++n) _Pragma("unroll") for (int k = 0; k < 2; ++k) \
        acc[ai][bj][m][n] = __builtin_amdgcn_mfma_f32_16x16x32_bf16(Bt[n][k], At[m][k], acc[ai][bj][m][n], 0, 0, 0); __builtin_amdgcn_s_setprio(0); } while (0)
#define PG8_WAIT_V(n) asm volatile("s_waitcnt vmcnt(" #n ")" ::: "memory")
#define PG8_WAIT_L(n) asm volatile("s_waitcnt lgkmcnt(" #n ")" ::: "memory")
#define PG8_BAR __builtin_amdgcn_s_barrier()
#define PG8_SCHED __builtin_amdgcn_sched_barrier(0)
    Unit cur, nxt; int ui = 0;
    if (!S.next(0, cur)) return;
    f32x4 acc[2][2][4][2];
#pragma unroll
    for (int a = 0; a < 2; ++a)
#pragma unroll
        for (int b = 0; b < 2; ++b)
#pragma unroll
            for (int m = 0; m < 4; ++m)
#pragma unroll
                for (int n = 0; n < 2; ++n) acc[a][b][m][n] = (f32x4){0.f, 0.f, 0.f, 0.f};
    bf16x8 At[4][2], B0[2][2], B1[2][2];
    const char* cA = (const char*)g.A + (size_t)cur.pm * tstep; const char* cB = (const char*)g.Bt + (size_t)cur.pn * tstep;
    S.a_ready(cur);
    if constexpr (SP2) {
        PG8_STAGE(PG8_SB(0, 0), cB, voffB); PG8_STAGE(PG8_SB(0, 1), cB + hstep, voffB); PG8_STAGE(PG8_SA(0, 0), cA, voffA); PG8_STAGE(PG8_SA(0, 1), cA + hstep, voffA);
        if (wr == 1) PG8_BAR;
        PG8_WAIT_V(2); PG8_BAR;
        PG8_STAGE(PG8_SB(1, 0), cB + kstep, voffB); PG8_STAGE(PG8_SA(1, 0), cA + kstep, voffA); PG8_STAGE(PG8_SB(1, 1), cB + hstep + kstep, voffB);
        PG8_WAIT_V(6); PG8_BAR;
    } else {
        PG8_STAGE(PG8_SB(0, 0), cB, voffB); PG8_STAGE(PG8_SA(0, 0), cA, voffA); PG8_STAGE(PG8_SB(0, 1), cB + hstep, voffB); PG8_STAGE(PG8_SA(0, 1), cA + hstep, voffA);
        if (wr == 1) PG8_BAR;
        PG8_WAIT_V(4); PG8_BAR;
        PG8_STAGE(PG8_SB(1, 0), cB + kstep, voffB); PG8_STAGE(PG8_SA(1, 0), cA + kstep, voffA); PG8_STAGE(PG8_SB(1, 1), cB + hstep + kstep, voffB);
        PG8_WAIT_V(6); PG8_BAR;
    }
    for (;;) {
        const bool has_next = S.next(ui + 1, nxt);
        const char* nA = has_next ? (const char*)g.A + (size_t)nxt.pm * tstep : cA; const char* nB = has_next ? (const char*)g.Bt + (size_t)nxt.pn * tstep : cB;
        for (int t = 0; t < nt; t += 2) {
            const bool last = (t == nt - 2);
            const char* a1 = cA + (size_t)(t + 1) * kstep;
            const char* a2 = last ? nA : cA + (size_t)(t + 2) * kstep; const char* b2 = last ? nB : cB + (size_t)(t + 2) * kstep;
            const char* a3 = a2 + kstep; const char* b3 = b2 + kstep;
            if (last && has_next) S.a_ready(nxt);
            if constexpr (SP2) {
            PG8_LDB(B0, 0, 0); PG8_LDB(B1, 0, 1); PG8_SCHED; PG8_LDA(At, 0, 0); PG8_STAGE(PG8_SA(1, 1), a1 + hstep, voffA);
            PG8_WAIT_V(8); PG8_WAIT_L(0); PG8_BAR; PG8_MMA(0, 0, At, B0); PG8_MMA(0, 1, At, B1); PG8_BAR; PG8_SCHED;
            PG8_LDA(At, 0, 1); PG8_STAGE(PG8_SB(0, 0), b2, voffB); PG8_STAGE(PG8_SB(0, 1), b2 + hstep, voffB); PG8_STAGE(PG8_SA(0, 0), a2, voffA);
            PG8_WAIT_V(8); PG8_WAIT_L(0); PG8_BAR; PG8_MMA(1, 0, At, B0); PG8_MMA(1, 1, At, B1); PG8_BAR; PG8_SCHED;
            PG8_LDB(B0, 1, 0); PG8_LDB(B1, 1, 1); PG8_SCHED; PG8_LDA(At, 1, 0); PG8_STAGE(PG8_SA(0, 1), a2 + hstep, voffA);
            PG8_WAIT_V(8); PG8_WAIT_L(0); PG8_BAR; PG8_MMA(0, 0, At, B0); PG8_MMA(0, 1, At, B1); PG8_BAR; PG8_SCHED;
            PG8_LDA(At, 1, 1); PG8_STAGE(PG8_SB(1, 0), b3, voffB); PG8_STAGE(PG8_SB(1, 1), b3 + hstep, voffB); PG8_STAGE(PG8_SA(1, 0), a3, voffA);
            PG8_WAIT_V(8); PG8_WAIT_L(0); PG8_BAR; PG8_MMA(1, 0, At, B0); PG8_MMA(1, 1, At, B1); PG8_BAR; PG8_SCHED;
            } else {
            PG8_LDB(B0, 0, 0); PG8_SCHED; PG8_LDA(At, 0, 0); PG8_STAGE(PG8_SA(1, 1), a1 + hstep, voffA);
            PG8_WAIT_L(8); PG8_BAR; PG8_WAIT_L(0); PG8_MMA(0, 0, At, B0); PG8_BAR; PG8_SCHED;
            PG8_LDB(B1, 0, 1); PG8_STAGE(PG8_SB(0, 0), b2, voffB);
            PG8_BAR; PG8_WAIT_L(0); PG8_MMA(0, 1, At, B1); PG8_BAR;
            PG8_LDA(At, 0, 1); PG8_STAGE(PG8_SA(0, 0), a2, voffA);
            PG8_BAR; PG8_WAIT_L(0); PG8_MMA(1, 0, At, B0); PG8_BAR; PG8_SCHED;
            PG8_STAGE(PG8_SB(0, 1), b2 + hstep, voffB);
            PG8_WAIT_V(6); PG8_BAR; PG8_MMA(1, 1, At, B1); PG8_BAR;
            PG8_LDB(B0, 1, 0); PG8_SCHED; PG8_LDA(At, 1, 0); PG8_STAGE(PG8_SA(0, 1), a2 + hstep, voffA);
            PG8_WAIT_L(8); PG8_BAR; PG8_WAIT_L(0); PG8_MMA(0, 0, At, B0); PG8_BAR; PG8_SCHED;
            PG8_LDB(B1, 1, 1); PG8_STAGE(PG8_SB(1, 0), b3, voffB);
            PG8_BAR; PG8_WAIT_L(0); PG8_MMA(0, 1, At, B1); PG8_BAR;
            PG8_LDA(At, 1, 1); PG8_STAGE(PG8_SA(1, 0), a3, voffA);
            PG8_BAR; PG8_WAIT_L(0); PG8_MMA(1, 0, At, B0); PG8_BAR; PG8_SCHED;
            PG8_STAGE(PG8_SB(1, 1), b3 + hstep, voffB);
            PG8_WAIT_V(6); PG8_BAR; PG8_MMA(1, 1, At, B1); PG8_BAR;
            }
        }
        if constexpr (ALIGN_EPI) { if (wr == 0) PG8_BAR; }
        if constexpr (!Epi::AFTER_DRAIN) { E(acc, cur, wr, wc, fr, fq); S.done(cur); }
        if (!has_next) break;
#pragma unroll
        for (int a = 0; a < 2; ++a)
#pragma unroll
            for (int b = 0; b < 2; ++b)
#pragma unroll
                for (int m = 0; m < 4; ++m)
#pragma unroll
                    for (int n = 0; n < 2; ++n) acc[a][b][m][n] = (f32x4){0.f, 0.f, 0.f, 0.f};
        cur = nxt; cA = nA; cB = nB; ++ui;
        if constexpr (ALIGN_EPI) { if (wr == 1) PG8_BAR; }
    }
    PG8_WAIT_V(0);
    if constexpr (!ALIGN_EPI) { if (wr == 0) PG8_BAR; }
    PG8_BAR;
    if constexpr (Epi::AFTER_DRAIN) { E.fused(acc, cur, wr, wc, fr, fq, lds, wid, lane); S.done(cur); }
#undef PG8_SA
#undef PG8_SB
#undef PG8_STAGE
#undef PG8_LDA
#undef PG8_LDB
#undef PG8_MMA
#undef PG8_WAIT_V
#undef PG8_WAIT_L
#undef PG8_BAR
#undef PG8_SCHED
}
}
#define LAS __attribute__((address_space(3)))
typedef unsigned short bf16;
typedef float f32x4 __attribute__((ext_vector_type(4)));
typedef float f32x2 __attribute__((ext_vector_type(2)));
typedef float f32x16 __attribute__((ext_vector_type(16)));
typedef short bf16x8 __attribute__((ext_vector_type(8)));
typedef short s16x4 __attribute__((ext_vector_type(4)));
typedef unsigned u32x4 __attribute__((ext_vector_type(4)));
typedef unsigned u32x2 __attribute__((ext_vector_type(2)));
using pg8::cvt_pk_bf16;
#define LDS_WAIT() asm volatile("s_waitcnt lgkmcnt(0)" ::: "memory")
#define CFENCE() asm volatile("" ::: "memory")

constexpr int DM = 1024, NB = 8, SEQ = 2048, CTX = 256, ML = NB * SEQ, MC = NB * CTX, MT = ML + MC, FF = 2816, NMOD = 9 * DM;
constexpr float ALPHA = 1.41421356237309515f, LN_EPS = 1e-5f, LOG2E = 1.4426950408889634f, QSCALE = 0.125f * 1.4426950408889634f;
constexpr size_t MiB = 1u << 20;
constexpr size_t WS_ROPE = 0, WS_MOD = 1 * MiB, WS_WIN = 2 * MiB, WS_WOUT = 46 * MiB, WS_NAQKV = 68 * MiB, WS_NAO = 74 * MiB, WS_WAQKV = 76 * MiB, WS_WAO = 79 * MiB;
constexpr size_t WS_H = 82 * MiB, WS_U = 154 * MiB, WS_HID = 190 * MiB, WS_QKV = 190 * MiB, WS_END = 298 * MiB;
constexpr size_t WIN_BYTES = (size_t)5632 * 1024 * 2, WOUT_BYTES = (size_t)1024 * 2816 * 2;
static_assert(WS_WIN + 4 * WIN_BYTES <= WS_WOUT && WS_WOUT + 4 * WOUT_BYTES <= WS_NAQKV && WS_H + (size_t)MT * DM * 4 <= WS_U && WS_U + (size_t)MT * DM * 2 <= WS_HID, "ws map");
static_assert(WS_HID + (size_t)MT * FF * 2 <= WS_END && WS_QKV + (size_t)MT * 3072 * 2 <= WS_END, "ws map");
constexpr int LDS_BYTES = 147456, NTHREADS = 512, NWAVES = 8;

struct Args { const float* in[16]; float* out; unsigned char* ws; };

__device__ __forceinline__ float wave_sum(float v) {
#pragma unroll
    for (int o = 1; o < 64; o <<= 1) v += __shfl_xor(v, o);
    return v;
}
__device__ __forceinline__ float silu_f(float x) { return x / (1.0f + __expf(-x)); }

__device__ __forceinline__ void transpose_item(const float* __restrict__ W, int K, int N, bf16* WT, int k0, int n0, int drow0, LAS float* scr, int lane) {
    const float* src = W + (size_t)(k0 + (lane >> 4)) * N + n0 + 4 * (lane & 15);
    f32x4 v[16];
#pragma unroll
    for (int i = 0; i < 16; ++i) v[i] = *(const f32x4*)(src + (size_t)(4 * i) * N);
#pragma unroll
    for (int i = 0; i < 16; ++i) { LAS float* d = scr + ((lane >> 4) + 4 * i) * 65 + 4 * (lane & 15); d[0] = v[i][0]; d[1] = v[i][1]; d[2] = v[i][2]; d[3] = v[i][3]; }
    LDS_WAIT();
    const int c = lane & 7;
#pragma unroll
    for (int j = 0; j < 8; ++j) { const int n = (lane >> 3) + 8 * j; const LAS float* s = scr + (8 * c) * 65 + n;
        u32x4 o; o.x = cvt_pk_bf16(s[0], s[65]); o.y = cvt_pk_bf16(s[2 * 65], s[3 * 65]); o.z = cvt_pk_bf16(s[4 * 65], s[5 * 65]); o.w = cvt_pk_bf16(s[6 * 65], s[7 * 65]);
        *(u32x4*)(WT + (size_t)(drow0 + n) * K + k0 + 8 * c) = o; }
    LDS_WAIT();
}
__device__ __forceinline__ void transpose_mat_item(const float* W, int K, int N, bf16* WT, bool swi, int r, LAS float* scr, int lane) {
    const int nblk = N >> 6, kb = r / nblk, nb = r - kb * nblk, n0 = nb * 64;
    int drow0 = n0;
    if (swi) { const int half = n0 >= FF ? 1 : 0, nn = n0 - half * FF; drow0 = (nn >> 7) * 256 + half * 128 + (nn & 127); }
    transpose_item(W, K, N, WT, kb * 64, n0, drow0, scr, lane);
}
__device__ __forceinline__ void mod_item(int item, const float* c, const float* cctx, const float* wmod, const float* bmod, float* MOD, LAS unsigned char* lds, int tid, int wave, int lane) {
    const int l = item / 72, nb = item - l * 72, n0 = nb * 128;
    LAS float* sc = (LAS float*)lds;
    LAS float* red = sc + 9 * 1024;
    for (int i = tid; i < 9 * 1024; i += NTHREADS) { const int mi = i >> 10, k = i & 1023; const float x = mi < 8 ? c[mi * 1024 + k] : cctx[k]; sc[i] = silu_f(x); }
    __syncthreads();
    float a0[9], a1[9];
#pragma unroll
    for (int mi = 0; mi < 9; ++mi) { a0[mi] = 0.f; a1[mi] = 0.f; }
    const float* wp = wmod + ((size_t)l * 1024 + wave * 128) * NMOD + n0 + 2 * lane;
    const LAS float* sp = sc + wave * 128;
#pragma unroll 8
    for (int k = 0; k < 128; ++k) { const f32x2 w = *(const f32x2*)(wp + (size_t)k * NMOD);
#pragma unroll
        for (int mi = 0; mi < 9; ++mi) { const float s = sp[mi * 1024 + k]; a0[mi] += s * w[0]; a1[mi] += s * w[1]; } }
#pragma unroll
    for (int mi = 0; mi < 9; ++mi) { red[(wave * 9 + mi) * 128 + 2 * lane] = a0[mi]; red[(wave * 9 + mi) * 128 + 2 * lane + 1] = a1[mi]; }
    __syncthreads();
    for (int i = tid; i < 9 * 128; i += NTHREADS) { const int mi = i >> 7, j = i & 127; float s = 0.f;
#pragma unroll
        for (int w = 0; w < 8; ++w) s += red[(w * 9 + mi) * 128 + j];
        MOD[((size_t)l * 9 + mi) * NMOD + n0 + j] = s + bmod[l * NMOD + n0 + j]; }
    __syncthreads();
}
__device__ __forceinline__ void modulate_rows(const float* xlat, const float* xctx, const float* MODl, int shift_idx, bf16* U, int gw, int NGW, int lane) {
    for (int row = gw; row < MT; row += NGW) {
        const float* src = row < ML ? xlat + (size_t)row * DM : xctx + (size_t)(row - ML) * DM;
        const int mi = row < ML ? (row >> 11) : 8;
        const float* sh = MODl + (size_t)mi * NMOD + shift_idx * DM; const float* scl = sh + DM;
#pragma unroll
        for (int j = 0; j < 4; ++j) { const int cc = 4 * lane + 256 * j;
            const f32x4 x = *(const f32x4*)(src + cc), s = *(const f32x4*)(sh + cc), sc = *(const f32x4*)(scl + cc);
            const f32x4 u = x * (sc + 1.0f) + s;
            u32x2 w; w.x = cvt_pk_bf16(u[0], u[1]); w.y = cvt_pk_bf16(u[2], u[3]);
            *(u32x2*)(U + (size_t)row * DM + cc) = w; }
    }
}
__device__ __forceinline__ void ln_rows(float* H, int nrows, const float* g, const float* b, float* outp, const float* MODn, int shift_idx, bf16* U, int gw, int NGW, int lane) {
    for (int row = gw; row < nrows; row += NGW) {
        const float* p = H + (size_t)row * DM;
        f32x4 v[4]; float s = 0.f;
#pragma unroll
        for (int j = 0; j < 4; ++j) { v[j] = *(const f32x4*)(p + 4 * lane + 256 * j); s += (v[j][0] + v[j][1]) + (v[j][2] + v[j][3]); }
        const float mean = wave_sum(s) * (1.0f / DM); float s2 = 0.f;
#pragma unroll
        for (int j = 0; j < 4; ++j) { v[j] = v[j] - mean; s2 += (v[j][0] * v[j][0] + v[j][1] * v[j][1]) + (v[j][2] * v[j][2] + v[j][3] * v[j][3]); }
        const float rstd = 1.0f / sqrtf(wave_sum(s2) * (1.0f / DM) + LN_EPS);
        const int mi = row < ML ? (row >> 11) : 8;
        float* op = (outp ? outp : H) + (size_t)row * DM;
#pragma unroll
        for (int j = 0; j < 4; ++j) { const int cc = 4 * lane + 256 * j;
            const f32x4 h = v[j] * rstd * *(const f32x4*)(g + cc) + *(const f32x4*)(b + cc);
            *(f32x4*)(op + cc) = h;
            if (MODn) { const float* sh = MODn + (size_t)mi * NMOD + shift_idx * DM;
                const f32x4 u = h * (*(const f32x4*)(sh + DM + cc) + 1.0f) + *(const f32x4*)(sh + cc);
                u32x2 w; w.x = cvt_pk_bf16(u[0], u[1]); w.y = cvt_pk_bf16(u[2], u[3]);
                *(u32x2*)(U + (size_t)row * DM + cc) = w; } }
    }
}

template <int KIND>
__device__ __forceinline__ void tile_desc(int t, int b, int rs, int r, int qt, int jlo, int& krow0, int& mtype, int& aux) {
    if (t < 8) { krow0 = ML + b * CTX + 32 * t; mtype = 0; aux = 0; return; }
    const int w = t - 8;
    if (KIND == 0) { const int i = w >> 1, half = w & 1; krow0 = b * SEQ + (rs + i) * 64 + 32 * half; mtype = 1; aux = (rs + i - r + 7) * 2 + half; }
    else { const int j = jlo + w, kt = qt - 4 + j; krow0 = b * SEQ + 32 * kt; mtype = (j == 0) ? 2 : ((j == 8) ? 3 : 0); aux = 0; }
}
template <int KIND>
__device__ __forceinline__ void attn_wave_unit(const bf16* __restrict__ QKV, int pitch, int colQ, int colK, int colV, int qrow0, int b, int r, int qt,
                                               const float* bias_src, bf16* __restrict__ O, int ocol, LAS unsigned char* wlds, int lane) {
    const int n = lane & 31, hh = lane >> 5;
    bf16x8 qf[4];
    { const bf16* qp = QKV + (size_t)(qrow0 + n) * pitch + colQ + 32 * hh;
#pragma unroll
      for (int ks = 0; ks < 4; ++ks) qf[ks] = *(const bf16x8*)(qp + 8 * ks); }
    LAS float* tb = (LAS float*)(wlds + 4096) + 64;
    if (KIND == 0) { for (int i = lane; i < 465; i += 64) tb[i] = bias_src[i] * LOG2E; LDS_WAIT(); }
    const int rs = (KIND == 0) ? min(max(r - 4, 0), 24) : 0;
    int jlo = 0, nt = 8;
    if (KIND == 0) nt = 24;
    if (KIND == 1) { jlo = max(0, 4 - qt); const int jhi = min(8, 67 - qt); nt = 8 + (jhi - jlo + 1); }
    const int qc = 32 * qt + n, wsn = min(max(qc - 8, 0), 48);
    f32x16 o0, o1;
#pragma unroll
    for (int i = 0; i < 16; ++i) { o0[i] = 0.f; o1[i] = 0.f; }
    float mrun = -INFINITY, lrun = 0.f;
    const int vrow = lane >> 3, vch = lane & 7;
    const int g16 = lane >> 4, i16 = lane & 15;
    const int traddr = ((4 * (g16 >> 1) + (i16 >> 2)) * 128) + (16 * (g16 & 1) + 4 * (i16 & 3)) * 2;
    bf16x8 kn[4]; u32x4 vn[4]; int mtype_n, aux_n;
#define ATT_LOAD(t_) do { int krow0_; tile_desc<KIND>((t_), b, rs, r, qt, jlo, krow0_, mtype_n, aux_n); \
        const bf16* kp_ = QKV + (size_t)(krow0_ + n) * pitch + colK + 32 * hh; \
        _Pragma("unroll") for (int ks = 0; ks < 4; ++ks) kn[ks] = *(const bf16x8*)(kp_ + 8 * ks); \
        const bf16* vp_ = QKV + (size_t)(krow0_ + vrow) * pitch + colV + 8 * vch; \
        _Pragma("unroll") for (int i = 0; i < 4; ++i) vn[i] = *(const u32x4*)(vp_ + (size_t)(8 * i) * pitch); } while (0)
    ATT_LOAD(0);
    for (int t = 0; t < nt; ++t) {
        bf16x8 kf[4]; u32x4 vc[4];
#pragma unroll
        for (int i = 0; i < 4; ++i) { kf[i] = kn[i]; vc[i] = vn[i]; }
        const int mtype = mtype_n, aux = aux_n;
        if (t + 1 < nt) ATT_LOAD(t + 1);
        f32x16 s;
#pragma unroll
        for (int i = 0; i < 16; ++i) s[i] = 0.f;
#pragma unroll
        for (int ks = 0; ks < 4; ++ks) s = __builtin_amdgcn_mfma_f32_32x32x16_bf16(kf[ks], qf[ks], s, 0, 0, 0);
        if (KIND == 0 && mtype == 1) {
            const int half = aux & 1, brow = aux >> 1;
            const int kc0 = 32 * half + 4 * hh;
            const LAS float* tp = tb + brow * 31 + (kc0 - qc + 15);
#pragma unroll
            for (int i = 0; i < 16; ++i) { const int ko = (i & 3) + 8 * (i >> 2); const bool valid = (unsigned)(kc0 + ko - wsn) < 16u; const float bv = tp[ko]; s[i] = valid ? s[i] + bv : -INFINITY; }
        }
        if (KIND == 1 && mtype == 2) {
#pragma unroll
            for (int i = 0; i < 16; ++i) { const int kk = (i & 3) + 8 * (i >> 2) + 4 * hh; s[i] = (kk >= n) ? s[i] : -INFINITY; }
        }
        if (KIND == 1 && mtype == 3) {
#pragma unroll
            for (int i = 0; i < 16; ++i) { const int kk = (i & 3) + 8 * (i >> 2) + 4 * hh; s[i] = (kk <= n) ? s[i] : -INFINITY; }
        }
        float tm = s[0];
#pragma unroll
        for (int i = 1; i < 16; ++i) tm = fmaxf(tm, s[i]);
        tm = fmaxf(tm, __shfl_xor(tm, 32));
        const float mnew = fmaxf(mrun, tm);
        const float alpha = __builtin_amdgcn_exp2f(mrun - mnew);
        float ps = 0.f;
#pragma unroll
        for (int i = 0; i < 16; ++i) { s[i] = __builtin_amdgcn_exp2f(s[i] - mnew); ps += s[i]; }
        ps += __shfl_xor(ps, 32);
        lrun = lrun * alpha + ps; mrun = mnew;
#pragma unroll
        for (int i = 0; i < 16; ++i) { o0[i] *= alpha; o1[i] *= alpha; }
        bf16x8 pf[2];
#pragma unroll
        for (int s2 = 0; s2 < 2; ++s2) { u32x4 w; w.x = cvt_pk_bf16(s[8 * s2 + 0], s[8 * s2 + 1]); w.y = cvt_pk_bf16(s[8 * s2 + 2], s[8 * s2 + 3]); w.z = cvt_pk_bf16(s[8 * s2 + 4], s[8 * s2 + 5]); w.w = cvt_pk_bf16(s[8 * s2 + 6], s[8 * s2 + 7]);
            pf[s2] = __builtin_bit_cast(bf16x8, w); }
        CFENCE();
#pragma unroll
        for (int i = 0; i < 4; ++i) *(LAS u32x4*)(wlds + (vrow + 8 * i) * 128 + 16 * vch) = vc[i];
        CFENCE();
        bf16x8 vf[2][2];
#pragma unroll
        for (int db = 0; db < 2; ++db)
#pragma unroll
            for (int s2 = 0; s2 < 2; ++s2) {
                const s16x4 lo = __builtin_amdgcn_ds_read_tr16_b64_v4i16((LAS s16x4*)(wlds + traddr + (16 * s2) * 128 + 64 * db));
                const s16x4 hi = __builtin_amdgcn_ds_read_tr16_b64_v4i16((LAS s16x4*)(wlds + traddr + (16 * s2 + 8) * 128 + 64 * db));
                bf16x8 f; f[0] = lo[0]; f[1] = lo[1]; f[2] = lo[2]; f[3] = lo[3]; f[4] = hi[0]; f[5] = hi[1]; f[6] = hi[2]; f[7] = hi[3];
                vf[db][s2] = f; }
        CFENCE();
        o0 = __builtin_amdgcn_mfma_f32_32x32x16_bf16(vf[0][0], pf[0], o0, 0, 0, 0);
        o0 = __builtin_amdgcn_mfma_f32_32x32x16_bf16(vf[0][1], pf[1], o0, 0, 0, 0);
        o1 = __builtin_amdgcn_mfma_f32_32x32x16_bf16(vf[1][0], pf[0], o1, 0, 0, 0);
        o1 = __builtin_amdgcn_mfma_f32_32x32x16_bf16(vf[1][1], pf[1], o1, 0, 0, 0);
    }
#undef ATT_LOAD
    if (KIND == 1) lrun += __builtin_amdgcn_exp2f(bias_src[0] * LOG2E - mrun);
    const float inv = 1.0f / lrun;
    bf16* op = O + (size_t)(qrow0 + n) * DM + ocol + 4 * hh;
#pragma unroll
    for (int g4 = 0; g4 < 4; ++g4) {
        u32x2 w0; w0.x = cvt_pk_bf16(o0[4 * g4 + 0] * inv, o0[4 * g4 + 1] * inv); w0.y = cvt_pk_bf16(o0[4 * g4 + 2] * inv, o0[4 * g4 + 3] * inv);
        u32x2 w1; w1.x = cvt_pk_bf16(o1[4 * g4 + 0] * inv, o1[4 * g4 + 1] * inv); w1.y = cvt_pk_bf16(o1[4 * g4 + 2] * inv, o1[4 * g4 + 3] * inv);
        *(u32x2*)(op + 8 * g4) = w0; *(u32x2*)(op + 32 + 8 * g4) = w1; }
    CFENCE();
}

__global__ void __launch_bounds__(NTHREADS) fwd_megakernel(Args a) {
    extern __shared__ __attribute__((aligned(16))) unsigned char lds_raw[];
    cg::grid_group grid = cg::this_grid();
    LAS unsigned char* lds = (LAS unsigned char*)lds_raw;
    const int tid = threadIdx.x, lane = tid & 63, wave = __builtin_amdgcn_readfirstlane(tid >> 6);
    const int G = gridDim.x, bx = blockIdx.x;
    const int gw = bx * NWAVES + wave, NGW = G * NWAVES;
    unsigned char* ws = a.ws;
    const float* x = a.in[0]; const float* cvec = a.in[1]; const float* ctx = a.in[2]; const float* cctx = a.in[3];
    const float* wmod = a.in[4]; const float* bmod = a.in[5]; const float* lng = a.in[6]; const float* lnb = a.in[7];
    const float* wfin = a.in[8]; const float* wfout = a.in[9]; const float* naqkv = a.in[10]; const float* nao = a.in[11]; const float* narpb = a.in[12];
    const float* waqkv = a.in[13]; const float* wao = a.in[14]; const float* wasink = a.in[15];
    float* ROPE = (float*)(ws + WS_ROPE); float* MOD = (float*)(ws + WS_MOD);
    bf16* WIN = (bf16*)(ws + WS_WIN); bf16* WOUT = (bf16*)(ws + WS_WOUT);
    bf16* NAQKV = (bf16*)(ws + WS_NAQKV); bf16* NAO = (bf16*)(ws + WS_NAO); bf16* WAQKV = (bf16*)(ws + WS_WAQKV); bf16* WAO = (bf16*)(ws + WS_WAO);
    float* H = (float*)(ws + WS_H); bf16* U = (bf16*)(ws + WS_U); bf16* HID = (bf16*)(ws + WS_HID); bf16* QKV = (bf16*)(ws + WS_QKV);
    bf16* ATTO = U;

    for (int it = bx; it < 144; it += G) mod_item(it, cvec, cctx, wmod, bmod, MOD, lds, tid, wave, lane);
    if (bx == G - 1) { for (int i = tid; i < 1024; i += NTHREADS) { const int pos = i >> 4, f = i & 15; const float inv = __builtin_amdgcn_exp2f(-(float)f * 0.8304820237218406f);
            const float ang = (float)pos * inv; ROPE[2 * i] = __cosf(ang); ROPE[2 * i + 1] = __sinf(ang); } }
    {
        LAS float* scr = (LAS float*)(lds + wave * 16640);
        constexpr int I_IN = 16 * 88, I_OUT = 44 * 16, I_NAQ = 16 * 48, I_O = 16 * 16, I_WAQ = 16 * 24;
        constexpr int NITEMS = 4 * I_IN + 4 * I_OUT + I_NAQ + I_O + I_WAQ + I_O;
        for (int it = gw; it < NITEMS; it += NGW) {
            int r = it;
            if (r < 4 * I_IN) { const int mtx = r / I_IN; transpose_mat_item(wfin + (size_t)mtx * 1024 * 5632, 1024, 5632, WIN + (size_t)mtx * 5632 * 1024, true, r - mtx * I_IN, scr, lane); continue; } r -= 4 * I_IN;
            if (r < 4 * I_OUT) { const int mtx = r / I_OUT; transpose_mat_item(wfout + (size_t)mtx * 2816 * 1024, 2816, 1024, WOUT + (size_t)mtx * 1024 * 2816, false, r - mtx * I_OUT, scr, lane); continue; } r -= 4 * I_OUT;
            if (r < I_NAQ) { transpose_mat_item(naqkv, 1024, 3072, NAQKV, false, r, scr, lane); continue; } r -= I_NAQ;
            if (r < I_O) { transpose_mat_item(nao, 1024, 1024, NAO, false, r, scr, lane); continue; } r -= I_O;
            if (r < I_WAQ) { transpose_mat_item(waqkv, 1024, 1536, WAQKV, false, r, scr, lane); continue; } r -= I_WAQ;
            transpose_mat_item(wao, 1024, 1024, WAO, false, r, scr, lane);
        }
    }
    grid.sync();
    modulate_rows(x, ctx, MOD, 0, U, gw, NGW, lane);
    grid.sync();

#pragma unroll 1
    for (int step = 0; step < 4; ++step) {
        const int layer = step >> 1, sub = step & 1;
        int lane_o = threadIdx.x; asm volatile("" : "+v"(lane_o)); const int lane = lane_o & 63;
        const int Mrows = (step == 3) ? ML : MT;
        const float* MODl = MOD + (size_t)layer * 9 * NMOD;
        {
            pg8::Gemm g{U, WIN + (size_t)step * 5632 * 1024, Mrows, 5632, 1024}; pg8::StaticOrder S; S.init(Mrows, 5632, G, bx);
            pg8::EpiSwiGLU E{HID, FF};
            pg8::gemm_phase<pg8::EpiSwiGLU, pg8::StaticOrder, true, true>(lds, g, S, E);
        }
        grid.sync();
        {
            pg8::Gemm g{HID, WOUT + (size_t)step * 1024 * 2816, Mrows, 1024, FF}; pg8::StaticOrder S; S.init(Mrows, 1024, G, bx);
            pg8::EpiRes E{step == 0 ? x : H, step == 0 ? ctx : H + (size_t)ML * DM, H, MODl + (sub ? 8 : 2) * DM, 0.5f, ALPHA};
            pg8::gemm_phase<pg8::EpiRes, pg8::StaticOrder, true, true>(lds, g, S, E);
        }
        grid.sync();
        {
            const int lnidx = layer * 3 + (sub ? 2 : 0);
            const float* MODn = sub == 0 ? MODl : (layer == 0 ? MOD + (size_t)9 * NMOD : nullptr);
            ln_rows(H, Mrows, lng + lnidx * DM, lnb + lnidx * DM, step == 3 ? a.out : nullptr, MODn, sub == 0 ? 3 : 0, U, gw, NGW, lane);
        }
        if (step == 3) break;
        grid.sync();
        if (sub == 0) {
            {
                const int Nq = layer == 0 ? 3072 : 1536;
                pg8::Gemm g{U, layer == 0 ? NAQKV : WAQKV, MT, Nq, 1024}; pg8::StaticOrder S; S.init(MT, Nq, G, bx);
                pg8::EpiQKV E{QKV, Nq, QSCALE, layer == 0 ? 0 : 1280, ROPE};
                pg8::gemm_phase<pg8::EpiQKV, pg8::StaticOrder, true, true>(lds, g, S, E);
            }
            grid.sync();
            {
                LAS unsigned char* wlds = lds + wave * 8192;
                if (layer == 0) {
                    for (int bu = bx; bu < 1152; bu += G) {
                        if (bu < 1024) { const int b = bu & 7, rest = bu >> 3, h = rest >> 3, r = (rest & 7) * 4 + (wave >> 1), qt = wave & 1;
                            attn_wave_unit<0>(QKV, 3072, h * 64, 1024 + h * 64, 2048 + h * 64, b * SEQ + r * 64 + 32 * qt, b, r, qt, narpb + h * 465, ATTO, h * 64, wlds, lane); }
                        else { const int cu = bu - 1024, b = cu & 7, h = cu >> 3;
                            attn_wave_unit<2>(QKV, 3072, h * 64, 1024 + h * 64, 2048 + h * 64, ML + b * CTX + 32 * wave, b, 0, 0, nullptr, ATTO, h * 64, wlds, lane); }
                    }
                } else {
                    for (int bu = bx; bu < 1024; bu += G) { const int b = bu & 7, rest = bu >> 3, kvh = rest >> 5, qp = rest & 31, h = 4 * kvh + (wave & 3), qt = 2 * qp + (wave >> 2);
                        attn_wave_unit<1>(QKV, 1536, h * 64, 1024 + kvh * 64, 1280 + kvh * 64, b * SEQ + 32 * qt, b, 0, qt, wasink + h, ATTO, h * 64, wlds, lane); }
                }
            }
            grid.sync();
            const int M2 = layer == 0 ? MT : ML;
            {
                pg8::Gemm g{ATTO, layer == 0 ? NAO : WAO, M2, 1024, 1024}; pg8::StaticOrder S; S.init(M2, 1024, G, bx);
                pg8::EpiRes E{H, H + (size_t)ML * DM, H, MODl + 5 * DM, 1.0f, ALPHA};
                pg8::gemm_phase<pg8::EpiRes, pg8::StaticOrder, true, true>(lds, g, S, E);
            }
            grid.sync();
            ln_rows(H, M2, lng + (layer * 3 + 1) * DM, lnb + (layer * 3 + 1) * DM, nullptr, MODl, 6, U, gw, NGW, lane);
            grid.sync();
        }
    }
}

extern "C" void kernel_launch(void* const* d_in, const int* in_sizes, int n_in, void* d_out, int out_size, void* d_ws, size_t ws_size, hipStream_t stream) {
    static int grid = 0;
    if (grid == 0) {
        if (n_in != 16 || ws_size < WS_END) { fprintf(stderr, "kernel_launch: expected 16 inputs and >= %zu bytes of workspace (got %d, %zu)\n", (size_t)WS_END, n_in, ws_size); grid = -1; return; }
        int dev = 0, cus = 0, per_cu = 0;
        hipGetDevice(&dev);
        hipDeviceGetAttribute(&cus, hipDeviceAttributeMultiprocessorCount, dev);
        if (hipFuncSetAttribute((const void*)fwd_megakernel, hipFuncAttributeMaxDynamicSharedMemorySize, LDS_BYTES) != hipSuccess) { fprintf(stderr, "kernel_launch: hipFuncSetAttribute failed\n"); grid = -1; return; }
        if (hipOccupancyMaxActiveBlocksPerMultiprocessor(&per_cu, (const void*)fwd_megakernel, NTHREADS, LDS_BYTES) != hipSuccess || per_cu < 1) { fprintf(stderr, "kernel_launch: occupancy query failed (%d)\n", per_cu); grid = -1; return; }
        grid = cus * per_cu;
    }
    if (grid < 0) return;
    Args a{};
    for (int i = 0; i < 16; ++i) a.in[i] = (const float*)d_in[i];
    a.out = (float*)d_out; a.ws = (unsigned char*)d_ws;
    void* args[] = {&a};
    hipError_t e = hipLaunchCooperativeKernel((const void*)fwd_megakernel, dim3(grid), dim3(NTHREADS), args, LDS_BYTES, stream);
    if (e != hipSuccess) fprintf(stderr, "kernel_launch: cooperative launch failed: %s (grid %d)\n", hipGetErrorString(e), grid);
}
```

```cpp
#include <hip/hip_runtime.h>
#include <hip/hip_cooperative_groups.h>
#include <cstdio>
#include <cstdint>
namespace cg = cooperative_groups;
namespace pg8 {
#define PG8_LAS __attribute__((address_space(3)))
typedef unsigned short bf16_t;
typedef short bf16x8 __attribute__((ext_vector_type(8)));
typedef float f32x4 __attribute__((ext_vector_type(4)));
typedef unsigned u32x4 __attribute__((ext_vector_type(4)));
constexpr int BM = 256, BK = 64, HALF = 128, HTB = HALF * BK * 2  , STAGE_BYTES = 8 * HTB, NXCD = 8, WGM = 8;

__host__ __device__ __forceinline__ int lds_byte(int r, int c) { const int st = (r >> 4) * 2 + (c >> 5), rr = r & 15, cc = c & 31, ob = rr * 64 + cc * 2; return st * 1024 + (ob ^ (((ob >> 9) & 1) << 5)); }
__host__ __device__ __forceinline__ void stage_rc(int b, int& R, int& C) { const int st = b / 1024, sb = b % 1024, swz = sb ^ (((sb >> 9) & 1) << 5); R = (st >> 1) * 16 + swz / 64; C = (st & 1) * 32 + (swz % 64) / 2; }
__host__ __device__ __forceinline__ int perm32(int rho) { const int n = rho >> 4, i = rho & 15; return 8 * (i >> 2) + 4 * n + (i & 3); }

struct Unit { int pm, pn; };
struct Gemm { const bf16_t* A; const bf16_t* Bt; int M, N, K; };

struct StaticOrder {
    int nM, nN, nwg, G, c;
    __host__ __device__ void init(int M, int N, int G_, int c_) { nM = M / BM; nN = N / BM; nwg = nM * nN; G = G_; c = c_; }
    __host__ __device__ bool next(int i, Unit& u) const {
        const long L = (long)i * G + c; if (L >= nwg) return false;
        int wgid = (int)L; { const int q = nwg / NXCD, r = nwg % NXCD, xcd = wgid % NXCD, off = wgid / NXCD; wgid = (xcd < r ? xcd * (q + 1) : r * (q + 1) + (xcd - r) * q) + off; }
        const int nig = WGM * nN, gid = wgid / nig, fm = gid * WGM, gsz = (nM - fm) < WGM ? (nM - fm) : WGM;
        u.pm = fm + ((wgid % nig) % gsz); u.pn = (wgid % nig) / gsz; return true;
    }
    __device__ __forceinline__ void a_ready(const Unit&) const {}
    __device__ __forceinline__ void done(const Unit&) const {}
};

__device__ __forceinline__ unsigned cvt_pk_bf16(float lo, float hi) { unsigned r; asm volatile("v_cvt_pk_bf16_f32 %0, %1, %2" : "=v"(r) : "v"(lo), "v"(hi)); return r; }
typedef float f32x2 __attribute__((ext_vector_type(2)));
typedef unsigned u32x4 __attribute__((ext_vector_type(4)));
struct EpiSwiGLU {
    static constexpr bool PERM = true, AFTER_DRAIN = false;
    bf16_t* O; int ldc;
    __device__ __forceinline__ void operator()(const f32x4 (&acc)[2][2][4][2], const Unit& u, int wr, int wc, int fr, int fq) const {
        const int row0 = u.pm * BM + wr * 64 + fr, col0 = u.pn * HALF + wc * 32 + 8 * fq;
#pragma unroll
        for (int ai = 0; ai < 2; ++ai)
#pragma unroll
            for (int m = 0; m < 4; ++m) {
                bf16_t* rowp = O + (size_t)(row0 + ai * HALF + m * 16) * ldc + col0;
                float h[8];
#pragma unroll
                for (int n = 0; n < 2; ++n)
#pragma unroll
                    for (int e = 0; e < 4; ++e) { const float a = acc[ai][0][m][n][e], v = acc[ai][1][m][n][e];
                        const float sg = __builtin_amdgcn_rcpf(1.0f + __builtin_amdgcn_exp2f(-1.4426950408889634f * a)); h[4 * n + e] = a * sg * v; }
                u32x4 w; w.x = cvt_pk_bf16(h[0], h[1]); w.y = cvt_pk_bf16(h[2], h[3]); w.z = cvt_pk_bf16(h[4], h[5]); w.w = cvt_pk_bf16(h[6], h[7]);
                *(u32x4*)rowp = w; }
    }
};
struct EpiRes {
    static constexpr bool PERM = false, AFTER_DRAIN = false;
    const float* res_lat; const float* res_ctx; float* out; const float* gate; float w; float alpha;
    __device__ __forceinline__ void operator()(const f32x4 (&acc)[2][2][4][2], const Unit& u, int wr, int wc, int fr, int fq) const {
        const int mi = u.pm < 64 ? (u.pm >> 3) : 8;
        const float* g = gate + (size_t)mi * 9216;
        const int col0 = u.pn * BM + wc * 32 + 4 * fq;
        f32x4 gv[2][2];
#pragma unroll
        for (int bj = 0; bj < 2; ++bj)
#pragma unroll
            for (int n = 0; n < 2; ++n) gv[bj][n] = *(const f32x4*)(g + col0 + bj * HALF + n * 16) * w;
        const float* rbase = u.pm < 64 ? res_lat + (size_t)(u.pm * BM) * 1024 : res_ctx + (size_t)(u.pm * BM - 16384) * 1024;
        float* obase = out + (size_t)(u.pm * BM) * 1024;
#pragma unroll
        for (int ai = 0; ai < 2; ++ai)
#pragma unroll
            for (int m = 0; m < 4; ++m) { const size_t off = (size_t)(ai * HALF + wr * 64 + m * 16 + fr) * 1024 + col0;
                f32x4 r[2][2];
#pragma unroll
                for (int bj = 0; bj < 2; ++bj)
#pragma unroll
                    for (int n = 0; n < 2; ++n) r[bj][n] = *(const f32x4*)(rbase + off + bj * HALF + n * 16);
#pragma unroll
                for (int bj = 0; bj < 2; ++bj)
#pragma unroll
                    for (int n = 0; n < 2; ++n) *(f32x4*)(obase + off + bj * HALF + n * 16) = r[bj][n] * alpha + gv[bj][n] * acc[ai][bj][m][n];
                asm volatile("" ::: "memory"); }
    }
};
struct EpiQKV {
    static constexpr bool PERM = true, AFTER_DRAIN = false;
    bf16_t* O; int ldc; float qscale; int ropecols; const float* ropetab;
    __device__ __forceinline__ void operator()(const f32x4 (&acc)[2][2][4][2], const Unit& u, int wr, int wc, int fr, int fq) const {
        const int row0 = u.pm * BM + wr * 64 + fr;
#pragma unroll
        for (int bj = 0; bj < 2; ++bj) {
            const int ct = u.pn * BM + bj * HALF + wc * 32, col0 = ct + 8 * fq;
            const float sc = ct < 1024 ? qscale : 1.0f;
            const bool dorope = (ct < ropecols) && (u.pm < 64);
            const float sgn = fq >= 2 ? 1.0f : -1.0f;
#pragma unroll
            for (int ai = 0; ai < 2; ++ai)
#pragma unroll
                for (int m = 0; m < 4; ++m) {
                    const int row = row0 + ai * HALF + m * 16;
                    f32x4 v0 = acc[ai][bj][m][0], v1 = acc[ai][bj][m][1];
                    if (dorope) {
                        f32x4 p0, p1;
#pragma unroll
                        for (int e = 0; e < 4; ++e) { p0[e] = __shfl_xor(v0[e], 32); p1[e] = __shfl_xor(v1[e], 32); }
                        const int t = row & 2047, pos = (wc & 1) ? (t & 63) : (t >> 6);
                        const f32x4* tp = (const f32x4*)(ropetab + (size_t)(pos * 16 + 8 * (fq & 1)) * 2);
                        const f32x4 c0 = tp[0], c1 = tp[1], c2 = tp[2], c3 = tp[3];
                        v0[0] = v0[0] * c0[0] + sgn * p0[0] * c0[1]; v0[1] = v0[1] * c0[2] + sgn * p0[1] * c0[3];
                        v0[2] = v0[2] * c1[0] + sgn * p0[2] * c1[1]; v0[3] = v0[3] * c1[2] + sgn * p0[3] * c1[3];
                        v1[0] = v1[0] * c2[0] + sgn * p1[0] * c2[1]; v1[1] = v1[1] * c2[2] + sgn * p1[1] * c2[3];
                        v1[2] = v1[2] * c3[0] + sgn * p1[2] * c3[1]; v1[3] = v1[3] * c3[2] + sgn * p1[3] * c3[3];
                    }
                    v0 = v0 * sc; v1 = v1 * sc;
                    u32x4 w; w.x = cvt_pk_bf16(v0[0], v0[1]); w.y = cvt_pk_bf16(v0[2], v0[3]); w.z = cvt_pk_bf16(v1[0], v1[1]); w.w = cvt_pk_bf16(v1[2], v1[3]);
                    *(u32x4*)(O + (size_t)row * ldc + col0) = w; }
        }
    }
};
template <class Epi, class Sched, bool ALIGN_EPI = false, bool SP2 = false>
__device__ __forceinline__ void gemm_phase(PG8_LAS unsigned char* lds, const Gemm g, const Sched& S, const Epi& E) {
    int tid_ = threadIdx.x; asm volatile("" : "+v"(tid_)); const int tid = tid_, wid = __builtin_amdgcn_readfirstlane(tid >> 6), lane = tid & 63, wr = wid >> 2, wc = wid & 3, fr = lane & 15, fq = lane >> 4;
    const int K = g.K, nt = K / BK;
    unsigned voffA[2], voffB[2];
#pragma unroll
    for (int i = 0; i < 2; ++i) { int R, C; stage_rc(tid * 16 + i * 8192, R, C); const int Rb = Epi::PERM ? ((R & ~31) + perm32(R & 31)) : R;
        voffA[i] = (unsigned)(R * K + C) * 2u; voffB[i] = (unsigned)(Rb * K + C) * 2u; }
    const size_t kstep = (size_t)(BK * 2);
    const size_t hstep = (size_t)HALF * K * 2;
    const size_t tstep = 2 * hstep;
    const unsigned ldsw = (unsigned)wid * 1024u;
    const int aoff = lds_byte(wr * 64 + fr, fq * 8), boff = lds_byte(wc * 32 + fr, fq * 8);
#define PG8_SA(b, h) (((b) * 2 + (h)) * HTB)
#define PG8_SB(b, h) ((4 + (b) * 2 + (h)) * HTB)
#define PG8_STAGE(bufoff, gbase, voff) do { _Pragma("unroll") for (int _i = 0; _i < 2; ++_i) \
        __builtin_amdgcn_global_load_lds((const unsigned*)((const char*)(gbase) + (voff)[_i]), (PG8_LAS unsigned*)(lds + (bufoff) + ldsw + _i * 8192), 16, 0, 0); } while (0)
#define PG8_LDA(dst, b, h) do { _Pragma("unroll") for (int m = 0; m < 4; ++m) _Pragma("unroll") for (int k = 0; k < 2; ++k) dst[m][k] = *(const PG8_LAS bf16x8*)(lds + PG8_SA(b, h) + aoff + m * 2048 + k * 1024); } while (0)
#define PG8_LDB(dst, b, h) do { _Pragma("unroll") for (int n = 0; n < 2; ++n) _Pragma("unroll") for (int k = 0; k < 2; ++k) dst[n][k] = *(const PG8_LAS bf16x8*)(lds + PG8_SB(b, h) + boff + n * 2048 + k * 1024); } while (0)
#define PG8_MMA(ai, bj, At, Bt) do { __builtin_amdgcn_s_setprio(1); _Pragma("unroll") for (int m = 0; m < 4; ++m) _Pragma("unroll") for (int n = 0; n < 2; ++n) _Pragma("unroll") for (int k = 0; k < 2; ++k) \
        acc[ai][bj][m][n] = __builtin_amdgcn_mfma_f32_16x16x32_bf16(Bt[n][k], At[m][k], acc[ai][bj][m][n], 0, 0, 0); __builtin_amdgcn_s_setprio(0); } while (0)
#define PG8_WAIT_V(n) asm volatile("s_waitcnt vmcnt(" #n ")" ::: "memory")
#define PG8_WAIT_L(n) asm volatile("s_waitcnt lgkmcnt(" #n ")" ::: "memory")
#define PG8_BAR __builtin_amdgcn_s_barrier()
#define PG8_SCHED __builtin_amdgcn_sched_barrier(0)
    Unit cur, nxt; int ui = 0;
    if (!S.next(0, cur)) return;
    f32x4 acc[2][2][4][2];
#pragma unroll
    for (int a = 0; a < 2; ++a)
#pragma unroll
        for (int b = 0; b < 2; ++b)
#pragma unroll
            for (int m = 0; m < 4; ++m)
#pragma unroll
                for (int n = 0; n < 2; ++n) acc[a][b][m][n] = (f32x4){0.f, 0.f, 0.f, 0.f};
    bf16x8 At[4][2], B0[2][2], B1[2][2];
    const char* cA = (const char*)g.A + (size_t)cur.pm * tstep; const char* cB = (const char*)g.Bt + (size_t)cur.pn * tstep;
    S.a_ready(cur);
    if constexpr (SP2) {
        PG8_STAGE(PG8_SB(0, 0), cB, voffB); PG8_STAGE(PG8_SB(0, 1), cB + hstep, voffB); PG8_STAGE(PG8_SA(0, 0), cA, voffA); PG8_STAGE(PG8_SA(0, 1), cA + hstep, voffA);
        if (wr == 1) PG8_BAR;
        PG8_WAIT_V(2); PG8_BAR;
        PG8_STAGE(PG8_SB(1, 0), cB + kstep, voffB); PG8_STAGE(PG8_SA(1, 0), cA + kstep, voffA); PG8_STAGE(PG8_SB(1, 1), cB + hstep + kstep, voffB);
        PG8_WAIT_V(6); PG8_BAR;
    } else {
        PG8_STAGE(PG8_SB(0, 0), cB, voffB); PG8_STAGE(PG8_SA(0, 0), cA, voffA); PG8_STAGE(PG8_SB(0, 1), cB + hstep, voffB); PG8_STAGE(PG8_SA(0, 1), cA + hstep, voffA);
        if (wr == 1) PG8_BAR;
        PG8_WAIT_V(4); PG8_BAR;
        PG8_STAGE(PG8_SB(1, 0), cB + kstep, voffB); PG8_STAGE(PG8_SA(1, 0), cA + kstep, voffA); PG8_STAGE(PG8_SB(1, 1), cB + hstep + kstep, voffB);
        PG8_WAIT_V(6); PG8_BAR;
    }
    for (;;) {
        const bool has_next = S.next(ui + 1, nxt);
        const char* nA = has_next ? (const char*)g.A + (size_t)nxt.pm * tstep : cA; const char* nB = has_next ? (const char*)g.Bt + (size_t)nxt.pn * tstep : cB;
        for (int t = 0; t < nt; t += 2) {
            const bool last = (t == nt - 2);
            const char* a1 = cA + (size_t)(t + 1) * kstep;
            const char* a2 = last ? nA : cA + (size_t)(t + 2) * kstep; const char* b2 = last ? nB : cB + (size_t)(t + 2) * kstep;
            const char* a3 = a2 + kstep; const char* b3 = b2 + kstep;
            if (last && has_next) S.a_ready(nxt);
            if constexpr (SP2) {
            PG8_LDB(B0, 0, 0); PG8_LDB(B1, 0, 1); PG8_SCHED; PG8_LDA(At, 0, 0); PG8_STAGE(PG8_SA(1, 1), a1 + hstep, voffA);
            PG8_WAIT_V(8); PG8_WAIT_L(0); PG8_BAR; PG8_MMA(0, 0, At, B0); PG8_MMA(0, 1, At, B1); PG8_BAR; PG8_SCHED;
            PG8_LDA(At, 0, 1); PG8_STAGE(PG8_SB(0, 0), b2, voffB); PG8_STAGE(PG8_SB(0, 1), b2 + hstep, voffB); PG8_STAGE(PG8_SA(0, 0), a2, voffA);
            PG8_WAIT_V(8); PG8_WAIT_L(0); PG8_BAR; PG8_MMA(1, 0, At, B0); PG8_MMA(1, 1, At, B1); PG8_BAR; PG8_SCHED;
            PG8_LDB(B0, 1, 0); PG8_LDB(B1, 1, 1); PG8_SCHED; PG8_LDA(At, 1, 0); PG8_STAGE(PG8_SA(0, 1), a2 + hstep, voffA);
            PG8_WAIT_V(8); PG8_WAIT_L(0); PG8_BAR; PG8_MMA(0, 0, At, B0); PG8_MMA(0, 1, At, B1); PG8_BAR; PG8_SCHED;
            PG8_LDA(At, 1, 1); PG8_STAGE(PG8_SB(1, 0), b3, voffB); PG8_STAGE(PG8_SB(1, 1), b3 + hstep, voffB); PG8_STAGE(PG8_SA(1, 0), a3, voffA);
            PG8_WAIT_V(8); PG8_WAIT_L(0); PG8_BAR; PG8_MMA(1, 0, At, B0); PG8_MMA(1, 1, At, B1); PG8_BAR; PG8_SCHED;
            } else {
            PG8_LDB(B0, 0, 0); PG8_SCHED; PG8_LDA(At, 0, 0); PG8_STAGE(PG8_SA(1, 1), a1 + hstep, voffA);
            PG8_WAIT_L(8); PG8_BAR; PG8_WAIT_L(0); PG8_MMA(0, 0, At, B0); PG8_BAR; PG8_SCHED;
            PG8_LDB(B1, 0, 1); PG8_STAGE(PG8_SB(0, 0), b2, voffB);
            PG8_BAR; PG8_WAIT_L(0); PG8_MMA(0, 1, At, B1); PG8_BAR;
            PG8_LDA(At, 0, 1); PG8_STAGE(PG8_SA(0, 0), a2, voffA);
            PG8_BAR; PG8_WAIT_L(0); PG8_MMA(1, 0, At, B0); PG8_BAR; PG8_SCHED;
            PG8_STAGE(PG8_SB(0, 1), b2 + hstep, voffB);
            PG8_WAIT_V(6); PG8_BAR; PG8_MMA(1, 1, At, B1); PG8_BAR;
            PG8_LDB(B0, 1, 0); PG8_SCHED; PG8_LDA(At, 1, 0); PG8_STAGE(PG8_SA(0, 1), a2 + hstep, voffA);
            PG8_WAIT_L(8); PG8_BAR; PG8_WAIT_L(0); PG8_MMA(0, 0, At, B0); PG8_BAR; PG8_SCHED;
            PG8_LDB(B1, 1, 1); PG8_STAGE(PG8_SB(1, 0), b3, voffB);
            PG8_BAR; PG8_WAIT_L(0); PG8_MMA(0, 1, At, B1); PG8_BAR;
            PG8_LDA(At, 1, 1); PG8_STAGE(PG8_SA(1, 0), a3, voffA);
            PG8_BAR; PG8_WAIT_L(0); PG8_MMA(1, 0, At, B0); PG8_BAR; PG8_SCHED;
            PG8_STAGE(PG8_SB(1, 1), b3 + hstep, voffB);
            PG8_WAIT_V(6); PG8_BAR; PG8_MMA(1, 1, At, B1); PG8_BAR;
            }
        }
        if constexpr (ALIGN_EPI) { if (wr == 0) PG8_BAR; }
        if constexpr (!Epi::AFTER_DRAIN) { E(acc, cur, wr, wc, fr, fq); S.done(cur); }
        if (!has_next) break;
#pragma unroll
        for (int a = 0; a < 2; ++a)
#pragma unroll
            for (int b = 0; b < 2; ++b)
#pragma unroll
                for (int m = 0; m < 4; ++m)
#pragma unroll
                    for (int n = 0; n < 2; ++n) acc[a][b][m][n] = (f32x4){0.f, 0.f, 0.f, 0.f};
        cur = nxt; cA = nA; cB = nB; ++ui;
        if constexpr (ALIGN_EPI) { if (wr == 1) PG8_BAR; }
    }
    PG8_WAIT_V(0);
    if constexpr (!ALIGN_EPI) { if (wr == 0) PG8_BAR; }
    PG8_BAR;
    if constexpr (Epi::AFTER_DRAIN) { E.fused(acc, cur, wr, wc, fr, fq, lds, wid, lane); S.done(cur); }
#undef PG8_SA
#undef PG8_SB
#undef PG8_STAGE
#undef PG8_LDA
#undef PG8_LDB
#undef PG8_MMA
#undef PG8_WAIT_V
#undef PG8_WAIT_L
#undef PG8_BAR
#undef PG8_SCHED
}
}
#define LAS __attribute__((address_space(3)))
typedef unsigned short bf16;
typedef float f32x4 __attribute__((ext_vector_type(4)));
typedef float f32x2 __attribute__((ext_vector_type(2)));
typedef float f32x16 __attribute__((ext_vector_type(16)));
typedef short bf16x8 __attribute__((ext_vector_type(8)));
typedef short s16x4 __attribute__((ext_vector_type(4)));
typedef unsigned u32x4 __attribute__((ext_vector_type(4)));
typedef unsigned u32x2 __attribute__((ext_vector_type(2)));
using pg8::cvt_pk_bf16;
#define LDS_WAIT() asm volatile("s_waitcnt lgkmcnt(0)" ::: "memory")
#define CFENCE() asm volatile("" ::: "memory")

constexpr int DM = 1024, NB = 8, SEQ = 2048, CTX = 256, ML = NB * SEQ, MC = NB * CTX, MT = ML + MC, FF = 2816, NMOD = 9 * DM;
constexpr float ALPHA = 1.41421356237309515f, LN_EPS = 1e-5f, LOG2E = 1.4426950408889634f, QSCALE = 0.125f * 1.4426950408889634f;
constexpr size_t MiB = 1u << 20;
constexpr int LDS_BYTES = 147456;
constexpr size_t WS_BAR = 512 * 1024;
constexpr int LDS_BARST = LDS_BYTES - 64;
constexpr size_t WS_ROPE = 0, WS_MOD = 1 * MiB, WS_WIN = 2 * MiB, WS_WOUT = 46 * MiB, WS_NAQKV = 68 * MiB, WS_NAO = 74 * MiB, WS_WAQKV = 76 * MiB, WS_WAO = 79 * MiB;
constexpr size_t WS_H = 82 * MiB, WS_U = 154 * MiB, WS_HID = 190 * MiB, WS_QKV = 190 * MiB, WS_END = 298 * MiB;
constexpr size_t WIN_BYTES = (size_t)5632 * 1024 * 2, WOUT_BYTES = (size_t)1024 * 2816 * 2;
static_assert(WS_WIN + 4 * WIN_BYTES <= WS_WOUT && WS_WOUT + 4 * WOUT_BYTES <= WS_NAQKV && WS_H + (size_t)MT * DM * 4 <= WS_U && WS_U + (size_t)MT * DM * 2 <= WS_HID, "ws map");
static_assert(WS_HID + (size_t)MT * FF * 2 <= WS_END && WS_QKV + (size_t)MT * 3072 * 2 <= WS_END, "ws map");
constexpr int NTHREADS = 512, NWAVES = 8;
constexpr int REP_PRO = 1, REP_ATT = 1, REP_G1 = 1, REP_SYNC = 1, REP_QKV = 1;

struct Args { const float* in[16]; float* out; unsigned char* ws; };

__device__ __forceinline__ float wave_sum(float v) {
#pragma unroll
    for (int o = 1; o < 64; o <<= 1) v += __shfl_xor(v, o);
    return v;
}
__device__ __forceinline__ float silu_f(float x) { return x / (1.0f + __expf(-x)); }

__device__ __forceinline__ void transpose_item(const float* __restrict__ W, int K, int N, bf16* WT, int k0, int n0, int drow0, LAS float* scr, int lane) {
    const float* src = W + (size_t)(k0 + (lane >> 4)) * N + n0 + 4 * (lane & 15);
    f32x4 v[16];
#pragma unroll
    for (int i = 0; i < 16; ++i) v[i] = *(const f32x4*)(src + (size_t)(4 * i) * N);
#pragma unroll
    for (int i = 0; i < 16; ++i) { LAS float* d = scr + ((lane >> 4) + 4 * i) * 65 + 4 * (lane & 15); d[0] = v[i][0]; d[1] = v[i][1]; d[2] = v[i][2]; d[3] = v[i][3]; }
    LDS_WAIT();
    const int c = lane & 7;
#pragma unroll
    for (int j = 0; j < 8; ++j) { const int n = (lane >> 3) + 8 * j; const LAS float* s = scr + (8 * c) * 65 + n;
        u32x4 o; o.x = cvt_pk_bf16(s[0], s[65]); o.y = cvt_pk_bf16(s[2 * 65], s[3 * 65]); o.z = cvt_pk_bf16(s[4 * 65], s[5 * 65]); o.w = cvt_pk_bf16(s[6 * 65], s[7 * 65]);
        *(u32x4*)(WT + (size_t)(drow0 + n) * K + k0 + 8 * c) = o; }
    LDS_WAIT();
}
__device__ __forceinline__ void transpose_mat_item(const float* W, int K, int N, bf16* WT, bool swi, int r, LAS float* scr, int lane) {
    const int nblk = N >> 6, kb = r / nblk, nb = r - kb * nblk, n0 = nb * 64;
    int drow0 = n0;
    if (swi) { const int half = n0 >= FF ? 1 : 0, nn = n0 - half * FF; drow0 = (nn >> 7) * 256 + half * 128 + (nn & 127); }
    transpose_item(W, K, N, WT, kb * 64, n0, drow0, scr, lane);
}
__device__ __forceinline__ void mod_item(int item, const float* c, const float* cctx, const float* wmod, const float* bmod, float* MOD, LAS unsigned char* lds, int tid, int wave, int lane) {
    const int l = item / 72, nb = item - l * 72, n0 = nb * 128;
    LAS float* sc = (LAS float*)lds;
    LAS float* red = sc + 9 * 1024;
    for (int i = tid; i < 9 * 1024; i += NTHREADS) { const int mi = i >> 10, k = i & 1023; const float x = mi < 8 ? c[mi * 1024 + k] : cctx[k]; sc[i] = silu_f(x); }
    __syncthreads();
    float a0[9], a1[9];
#pragma unroll
    for (int mi = 0; mi < 9; ++mi) { a0[mi] = 0.f; a1[mi] = 0.f; }
    const float* wp = wmod + ((size_t)l * 1024 + wave * 128) * NMOD + n0 + 2 * lane;
    const LAS float* sp = sc + wave * 128;
#pragma unroll 8
    for (int k = 0; k < 128; ++k) { const f32x2 w = *(const f32x2*)(wp + (size_t)k * NMOD);
#pragma unroll
        for (int mi = 0; mi < 9; ++mi) { const float s = sp[mi * 1024 + k]; a0[mi] += s * w[0]; a1[mi] += s * w[1]; } }
#pragma unroll
    for (int mi = 0; mi < 9; ++mi) { red[(wave * 9 + mi) * 128 + 2 * lane] = a0[mi]; red[(wave * 9 + mi) * 128 + 2 * lane + 1] = a1[mi]; }
    __syncthreads();
    for (int i = tid; i < 9 * 128; i += NTHREADS) { const int mi = i >> 7, j = i & 127; float s = 0.f;
#pragma unroll
        for (int w = 0; w < 8; ++w) s += red[(w * 9 + mi) * 128 + j];
        MOD[((size_t)l * 9 + mi) * NMOD + n0 + j] = s + bmod[l * NMOD + n0 + j]; }
    __syncthreads();
}
__device__ __forceinline__ void modulate_rows(const float* xlat, const float* xctx, const float* MODl, int shift_idx, bf16* U, int gw, int NGW, int lane) {
    for (int row = gw; row < MT; row += NGW) {
        const float* src = row < ML ? xlat + (size_t)row * DM : xctx + (size_t)(row - ML) * DM;
        const int mi = row < ML ? (row >> 11) : 8;
        const float* sh = MODl + (size_t)mi * NMOD + shift_idx * DM; const float* scl = sh + DM;
#pragma unroll
        for (int j = 0; j < 4; ++j) { const int cc = 4 * lane + 256 * j;
            const f32x4 x = *(const f32x4*)(src + cc), s = *(const f32x4*)(sh + cc), sc = *(const f32x4*)(scl + cc);
            const f32x4 u = x * (sc + 1.0f) + s;
            u32x2 w; w.x = cvt_pk_bf16(u[0], u[1]); w.y = cvt_pk_bf16(u[2], u[3]);
            *(u32x2*)(U + (size_t)row * DM + cc) = w; }
    }
}
__device__ __forceinline__ void ln_rows(float* H, int nrows, const float* g, const float* b, float* outp, const float* MODn, int shift_idx, bf16* U, int gw, int NGW, int lane) {
    for (int row = gw; row < nrows; row += NGW) {
        const float* p = H + (size_t)row * DM;
        f32x4 v[4]; float s = 0.f;
#pragma unroll
        for (int j = 0; j < 4; ++j) { v[j] = *(const f32x4*)(p + 4 * lane + 256 * j); s += (v[j][0] + v[j][1]) + (v[j][2] + v[j][3]); }
        const float mean = wave_sum(s) * (1.0f / DM); float s2 = 0.f;
#pragma unroll
        for (int j = 0; j < 4; ++j) { v[j] = v[j] - mean; s2 += (v[j][0] * v[j][0] + v[j][1] * v[j][1]) + (v[j][2] * v[j][2] + v[j][3] * v[j][3]); }
        const float rstd = 1.0f / sqrtf(wave_sum(s2) * (1.0f / DM) + LN_EPS);
        const int mi = row < ML ? (row >> 11) : 8;
        float* op = (outp ? outp : H) + (size_t)row * DM;
#pragma unroll
        for (int j = 0; j < 4; ++j) { const int cc = 4 * lane + 256 * j;
            const f32x4 h = v[j] * rstd * *(const f32x4*)(g + cc) + *(const f32x4*)(b + cc);
            *(f32x4*)(op + cc) = h;
            if (MODn) { const float* sh = MODn + (size_t)mi * NMOD + shift_idx * DM;
                const f32x4 u = h * (*(const f32x4*)(sh + DM + cc) + 1.0f) + *(const f32x4*)(sh + cc);
                u32x2 w; w.x = cvt_pk_bf16(u[0], u[1]); w.y = cvt_pk_bf16(u[2], u[3]);
                *(u32x2*)(U + (size_t)row * DM + cc) = w; } }
    }
}

template <int KIND>
__device__ __forceinline__ void tile_desc(int t, int b, int rs, int r, int qt, int jlo, int& krow0, int& mtype, int& aux) {
    if (t < 8) { krow0 = ML + b * CTX + 32 * t; mtype = 0; aux = 0; return; }
    const int w = t - 8;
    if (KIND == 0) { const int i = w >> 1, half = w & 1; krow0 = b * SEQ + (rs + i) * 64 + 32 * half; mtype = 1; aux = (rs + i - r + 7) * 2 + half; }
    else { const int j = jlo + w, kt = qt - 4 + j; krow0 = b * SEQ + 32 * kt; mtype = (j == 0) ? 2 : ((j == 8) ? 3 : 0); aux = 0; }
}
template <int KIND>
__device__ __forceinline__ void attn_wave_unit(const bf16* __restrict__ QKV, int pitch, int colQ, int colK, int colV, int qrow0, int b, int r, int qt,
                                               const float* bias_src, bf16* __restrict__ O, int ocol, LAS unsigned char* wlds, int lane) {
    const int n = lane & 31, hh = lane >> 5;
    bf16x8 qf[4];
    { const bf16* qp = QKV + (size_t)(qrow0 + n) * pitch + colQ + 32 * hh;
#pragma unroll
      for (int ks = 0; ks < 4; ++ks) qf[ks] = *(const bf16x8*)(qp + 8 * ks); }
    LAS float* tb = (LAS float*)(wlds + 4096) + 64;
    if (KIND == 0) { for (int i = lane; i < 465; i += 64) tb[i] = bias_src[i] * LOG2E; LDS_WAIT(); }
    const int rs = (KIND == 0) ? min(max(r - 4, 0), 24) : 0;
    int jlo = 0, nt = 8;
    if (KIND == 0) nt = 24;
    if (KIND == 1) { jlo = max(0, 4 - qt); const int jhi = min(8, 67 - qt); nt = 8 + (jhi - jlo + 1); }
    const int qc = 32 * qt + n, wsn = min(max(qc - 8, 0), 48);
    f32x16 o0, o1;
#pragma unroll
    for (int i = 0; i < 16; ++i) { o0[i] = 0.f; o1[i] = 0.f; }
    float mrun = -INFINITY, lrun = 0.f;
    const int vrow = lane >> 3, vch = lane & 7;
    const int g16 = lane >> 4, i16 = lane & 15;
    const int traddr = ((4 * (g16 >> 1) + (i16 >> 2)) * 128) + (16 * (g16 & 1) + 4 * (i16 & 3)) * 2;
    bf16x8 kn[4]; u32x4 vn[4]; int mtype_n, aux_n;
#define ATT_LOAD(t_) do { int krow0_; tile_desc<KIND>((t_), b, rs, r, qt, jlo, krow0_, mtype_n, aux_n); \
        const bf16* kp_ = QKV + (size_t)(krow0_ + n) * pitch + colK + 32 * hh; \
        _Pragma("unroll") for (int ks = 0; ks < 4; ++ks) kn[ks] = *(const bf16x8*)(kp_ + 8 * ks); \
        const bf16* vp_ = QKV + (size_t)(krow0_ + vrow) * pitch + colV + 8 * vch; \
        _Pragma("unroll") for (int i = 0; i < 4; ++i) vn[i] = *(const u32x4*)(vp_ + (size_t)(8 * i) * pitch); } while (0)
    ATT_LOAD(0);
    for (int t = 0; t < nt; ++t) {
        bf16x8 kf[4]; u32x4 vc[4];
#pragma unroll
        for (int i = 0; i < 4; ++i) { kf[i] = kn[i]; vc[i] = vn[i]; }
        const int mtype = mtype_n, aux = aux_n;
        if (t + 1 < nt) ATT_LOAD(t + 1);
        f32x16 s;
#pragma unroll
        for (int i = 0; i < 16; ++i) s[i] = 0.f;
#pragma unroll
        for (int ks = 0; ks < 4; ++ks) s = __builtin_amdgcn_mfma_f32_32x32x16_bf16(kf[ks], qf[ks], s, 0, 0, 0);
        if (KIND == 0 && mtype == 1) {
            const int half = aux & 1, brow = aux >> 1;
            const int kc0 = 32 * half + 4 * hh;
            const LAS float* tp = tb + brow * 31 + (kc0 - qc + 15);
#pragma unroll
            for (int i = 0; i < 16; ++i) { const int ko = (i & 3) + 8 * (i >> 2); const bool valid = (unsigned)(kc0 + ko - wsn) < 16u; const float bv = tp[ko]; s[i] = valid ? s[i] + bv : -INFINITY; }
        }
        if (KIND == 1 && mtype == 2) {
#pragma unroll
            for (int i = 0; i < 16; ++i) { const int kk = (i & 3) + 8 * (i >> 2) + 4 * hh; s[i] = (kk >= n) ? s[i] : -INFINITY; }
        }
        if (KIND == 1 && mtype == 3) {
#pragma unroll
            for (int i = 0; i < 16; ++i) { const int kk = (i & 3) + 8 * (i >> 2) + 4 * hh; s[i] = (kk <= n) ? s[i] : -INFINITY; }
        }
        float tm = s[0];
#pragma unroll
        for (int i = 1; i < 16; ++i) tm = fmaxf(tm, s[i]);
        tm = fmaxf(tm, __shfl_xor(tm, 32));
        const float mnew = fmaxf(mrun, tm);
        const float alpha = __builtin_amdgcn_exp2f(mrun - mnew);
        float ps = 0.f;
#pragma unroll
        for (int i = 0; i < 16; ++i) { s[i] = __builtin_amdgcn_exp2f(s[i] - mnew); ps += s[i]; }
        ps += __shfl_xor(ps, 32);
        lrun = lrun * alpha + ps; mrun = mnew;
#pragma unroll
        for (int i = 0; i < 16; ++i) { o0[i] *= alpha; o1[i] *= alpha; }
        bf16x8 pf[2];
#pragma unroll
        for (int s2 = 0; s2 < 2; ++s2) { u32x4 w; w.x = cvt_pk_bf16(s[8 * s2 + 0], s[8 * s2 + 1]); w.y = cvt_pk_bf16(s[8 * s2 + 2], s[8 * s2 + 3]); w.z = cvt_pk_bf16(s[8 * s2 + 4], s[8 * s2 + 5]); w.w = cvt_pk_bf16(s[8 * s2 + 6], s[8 * s2 + 7]);
            pf[s2] = __builtin_bit_cast(bf16x8, w); }
        CFENCE();
#pragma unroll
        for (int i = 0; i < 4; ++i) *(LAS u32x4*)(wlds + (vrow + 8 * i) * 128 + 16 * vch) = vc[i];
        CFENCE();
        bf16x8 vf[2][2];
#pragma unroll
        for (int db = 0; db < 2; ++db)
#pragma unroll
            for (int s2 = 0; s2 < 2; ++s2) {
                const s16x4 lo = __builtin_amdgcn_ds_read_tr16_b64_v4i16((LAS s16x4*)(wlds + traddr + (16 * s2) * 128 + 64 * db));
                const s16x4 hi = __builtin_amdgcn_ds_read_tr16_b64_v4i16((LAS s16x4*)(wlds + traddr + (16 * s2 + 8) * 128 + 64 * db));
                bf16x8 f; f[0] = lo[0]; f[1] = lo[1]; f[2] = lo[2]; f[3] = lo[3]; f[4] = hi[0]; f[5] = hi[1]; f[6] = hi[2]; f[7] = hi[3];
                vf[db][s2] = f; }
        CFENCE();
        o0 = __builtin_amdgcn_mfma_f32_32x32x16_bf16(vf[0][0], pf[0], o0, 0, 0, 0);
        o0 = __builtin_amdgcn_mfma_f32_32x32x16_bf16(vf[0][1], pf[1], o0, 0, 0, 0);
        o1 = __builtin_amdgcn_mfma_f32_32x32x16_bf16(vf[1][0], pf[0], o1, 0, 0, 0);
        o1 = __builtin_amdgcn_mfma_f32_32x32x16_bf16(vf[1][1], pf[1], o1, 0, 0, 0);
    }
#undef ATT_LOAD
    if (KIND == 1) lrun += __builtin_amdgcn_exp2f(bias_src[0] * LOG2E - mrun);
    const float inv = 1.0f / lrun;
    bf16* op = O + (size_t)(qrow0 + n) * DM + ocol + 4 * hh;
#pragma unroll
    for (int g4 = 0; g4 < 4; ++g4) {
        u32x2 w0; w0.x = cvt_pk_bf16(o0[4 * g4 + 0] * inv, o0[4 * g4 + 1] * inv); w0.y = cvt_pk_bf16(o0[4 * g4 + 2] * inv, o0[4 * g4 + 3] * inv);
        u32x2 w1; w1.x = cvt_pk_bf16(o1[4 * g4 + 0] * inv, o1[4 * g4 + 1] * inv); w1.y = cvt_pk_bf16(o1[4 * g4 + 2] * inv, o1[4 * g4 + 3] * inv);
        *(u32x2*)(op + 8 * g4) = w0; *(u32x2*)(op + 32 + 8 * g4) = w1; }
    CFENCE();
}

#define XB_TMO      128
#define XB_XCNT(j)  (256  + 64 * (j))
#define XB_XSUB(j)  (1280 + 64 * (j))
#define XB_XGEN(j)  (2304 + 64 * (j))
#define XB_TOP      3328
#define XB_TOPGEN   3392
#define XCD_BAR_WORDS 3456
#define XB_SPIN_CAP (1u << 18)

__device__ __forceinline__ unsigned xb_ld(unsigned* p)              { return __hip_atomic_load(p, __ATOMIC_RELAXED, __HIP_MEMORY_SCOPE_AGENT); }
__device__ __forceinline__ unsigned xb_add(unsigned* p, unsigned v) { return __hip_atomic_fetch_add(p, v, __ATOMIC_RELAXED, __HIP_MEMORY_SCOPE_AGENT); }
__device__ __forceinline__ unsigned xb_xcc_id() { return (unsigned)__builtin_amdgcn_s_getreg((3 << 11) | 20) & 0xFu; }
#define XB_SPIN(cond, bar) do { unsigned _sp = 0; while (cond) { __builtin_amdgcn_s_sleep(1); \
    if ((++_sp & 255u) == 0u) { if (xb_ld(&(bar)[XB_TMO])) break; if (_sp > XB_SPIN_CAP) { atomicAdd(&(bar)[XB_TMO], 1u); break; } } } } while (0)

struct XcdBarrier {
    unsigned* bar; unsigned x;
    volatile LAS unsigned* st;
};

__device__ __forceinline__ XcdBarrier xcd_barrier_post(unsigned* bar, volatile LAS unsigned* st) {
    XcdBarrier b; b.bar = bar; b.x = xb_xcc_id(); b.st = st;
    if (threadIdx.x == 0) (void)xb_add(&bar[XB_XCNT(b.x)], 1u);
    return b;
}
__device__ __forceinline__ void xcd_barrier_complete(unsigned* bar, unsigned x, unsigned& nloc, unsigned& nx) {
    const unsigned G = gridDim.x * gridDim.y * gridDim.z;
    unsigned sum, cnt, mine, sp = 0u;
    for (;;) {
        sum = 0u; cnt = 0u; mine = 0u;
#pragma unroll
        for (unsigned j = 0; j < 16; ++j) { const unsigned c = xb_ld(&bar[XB_XCNT(j)]); sum += c; cnt += (c > 0u) ? 1u : 0u; mine = (j == x) ? c : mine; }
        if (sum == G) break;
        __builtin_amdgcn_s_sleep(1);
        if ((++sp & 255u) == 0u) { if (xb_ld(&bar[XB_TMO])) break; if (sp > XB_SPIN_CAP) { atomicAdd(&bar[XB_TMO], 1u); break; } }
    }
    nloc = mine > 0u ? mine : 1u; nx = cnt > 0u ? cnt : 1u;
}

__device__ __forceinline__ void xcd_barrier(const XcdBarrier& b) {
    asm volatile("s_waitcnt vmcnt(0)" ::: "memory");
    __syncthreads();
    if (threadIdx.x == 0) {
        unsigned* bar = b.bar;
        __builtin_amdgcn_s_waitcnt(0);
        unsigned nloc = b.st[0], nx = b.st[1];
        if (nloc == 0u) { xcd_barrier_complete(bar, b.x, nloc, nx); b.st[0] = nloc; b.st[1] = nx; }
        const unsigned old = xb_add(&bar[XB_XSUB(b.x)], 1u);
        const unsigned gen = old / nloc;
        if (old + 1u == (gen + 1u) * nloc) {
            __builtin_amdgcn_fence(__ATOMIC_RELEASE, "agent");
            asm volatile("s_waitcnt vmcnt(0)" ::: "memory");
            const unsigned og = xb_add(&bar[XB_TOP], 1u);
            const unsigned tg = og / nx;
            if (og + 1u == (tg + 1u) * nx) xb_add(&bar[XB_TOPGEN], 1u);
            else XB_SPIN(xb_ld(&bar[XB_TOPGEN]) == tg, bar);
            __builtin_amdgcn_fence(__ATOMIC_ACQUIRE, "agent");
            xb_add(&bar[XB_XGEN(b.x)], 1u);
            asm volatile("s_waitcnt vmcnt(0)" ::: "memory");
        } else {
            XB_SPIN(xb_ld(&bar[XB_XGEN(b.x)]) == gen, bar);
            __builtin_amdgcn_fence(__ATOMIC_ACQUIRE, "agent");
            asm volatile("s_waitcnt vmcnt(0)" ::: "memory");
        }
    }
    __syncthreads();
}

__global__ void __launch_bounds__(NTHREADS) fwd_megakernel(Args a) {
    extern __shared__ __attribute__((aligned(16))) unsigned char lds_raw[];
    cg::grid_group grid = cg::this_grid();
    LAS unsigned char* lds = (LAS unsigned char*)lds_raw;
    const int tid = threadIdx.x, lane = tid & 63, wave = __builtin_amdgcn_readfirstlane(tid >> 6);
    const int G = gridDim.x, bx = blockIdx.x;
    const int gw = bx * NWAVES + wave, NGW = G * NWAVES;
    unsigned char* ws = a.ws;
    const float* x = a.in[0]; const float* cvec = a.in[1]; const float* ctx = a.in[2]; const float* cctx = a.in[3];
    const float* wmod = a.in[4]; const float* bmod = a.in[5]; const float* lng = a.in[6]; const float* lnb = a.in[7];
    const float* wfin = a.in[8]; const float* wfout = a.in[9]; const float* naqkv = a.in[10]; const float* nao = a.in[11]; const float* narpb = a.in[12];
    const float* waqkv = a.in[13]; const float* wao = a.in[14]; const float* wasink = a.in[15];
    float* ROPE = (float*)(ws + WS_ROPE); float* MOD = (float*)(ws + WS_MOD);
    bf16* WIN = (bf16*)(ws + WS_WIN); bf16* WOUT = (bf16*)(ws + WS_WOUT);
    bf16* NAQKV = (bf16*)(ws + WS_NAQKV); bf16* NAO = (bf16*)(ws + WS_NAO); bf16* WAQKV = (bf16*)(ws + WS_WAQKV); bf16* WAO = (bf16*)(ws + WS_WAO);
    float* H = (float*)(ws + WS_H); bf16* U = (bf16*)(ws + WS_U); bf16* HID = (bf16*)(ws + WS_HID); bf16* QKV = (bf16*)(ws + WS_QKV);
    bf16* ATTO = U;

    unsigned* barw = (unsigned*)(ws + WS_BAR);
    volatile LAS unsigned* barst = (volatile LAS unsigned*)(lds + LDS_BARST);
    if (bx == 0) { for (int i = tid; i < XCD_BAR_WORDS; i += NTHREADS) __hip_atomic_store(barw + i, 0u, __ATOMIC_RELAXED, __HIP_MEMORY_SCOPE_AGENT); }
    if (tid == 0) { barst[0] = 0u; barst[1] = 0u; }
    __syncthreads();
    for (int rep = 0; rep < REP_PRO; ++rep) {
    for (int it = bx; it < 144; it += G) mod_item(it, cvec, cctx, wmod, bmod, MOD, lds, tid, wave, lane);
    if (bx == G - 1) { for (int i = tid; i < 1024; i += NTHREADS) { const int pos = i >> 4, f = i & 15; const float inv = __builtin_amdgcn_exp2f(-(float)f * 0.8304820237218406f);
            const float ang = (float)pos * inv; ROPE[2 * i] = __cosf(ang); ROPE[2 * i + 1] = __sinf(ang); } }
    {
        LAS float* scr = (LAS float*)(lds + wave * 16640);
        constexpr int I_IN = 16 * 88, I_OUT = 44 * 16, I_NAQ = 16 * 48, I_O = 16 * 16, I_WAQ = 16 * 24;
        constexpr int NITEMS = 4 * I_IN + 4 * I_OUT + I_NAQ + I_O + I_WAQ + I_O;
        for (int it = gw; it < NITEMS; it += NGW) {
            int r = it;
            if (r < 4 * I_IN) { const int mtx = r / I_IN; transpose_mat_item(wfin + (size_t)mtx * 1024 * 5632, 1024, 5632, WIN + (size_t)mtx * 5632 * 1024, true, r - mtx * I_IN, scr, lane); continue; } r -= 4 * I_IN;
            if (r < 4 * I_OUT) { const int mtx = r / I_OUT; transpose_mat_item(wfout + (size_t)mtx * 2816 * 1024, 2816, 1024, WOUT + (size_t)mtx * 1024 * 2816, false, r - mtx * I_OUT, scr, lane); continue; } r -= 4 * I_OUT;
            if (r < I_NAQ) { transpose_mat_item(naqkv, 1024, 3072, NAQKV, false, r, scr, lane); continue; } r -= I_NAQ;
            if (r < I_O) { transpose_mat_item(nao, 1024, 1024, NAO, false, r, scr, lane); continue; } r -= I_O;
            if (r < I_WAQ) { transpose_mat_item(waqkv, 1024, 1536, WAQKV, false, r, scr, lane); continue; } r -= I_WAQ;
            transpose_mat_item(wao, 1024, 1024, WAO, false, r, scr, lane);
        }
    }
    __syncthreads();
    }
    grid.sync();
    const XcdBarrier xb = xcd_barrier_post(barw, barst);
    for (int rep = 1; rep < REP_SYNC; ++rep) xcd_barrier(xb);
    modulate_rows(x, ctx, MOD, 0, U, gw, NGW, lane);
    xcd_barrier(xb);

#pragma unroll 1
    for (int step = 0; step < 4; ++step) {
        const int layer = step >> 1, sub = step & 1;
        int lane_o = threadIdx.x; asm volatile("" : "+v"(lane_o)); const int lane = lane_o & 63;
        const int Mrows = (step == 3) ? ML : MT;
        const float* MODl = MOD + (size_t)layer * 9 * NMOD;
        for (int rep = 0; rep < REP_G1; ++rep) {
            pg8::Gemm g{U, WIN + (size_t)step * 5632 * 1024, Mrows, 5632, 1024}; pg8::StaticOrder S; S.init(Mrows, 5632, G, bx);
            pg8::EpiSwiGLU E{HID, FF};
            pg8::gemm_phase<pg8::EpiSwiGLU, pg8::StaticOrder, true, true>(lds, g, S, E);
        }
        xcd_barrier(xb);
        {
            pg8::Gemm g{HID, WOUT + (size_t)step * 1024 * 2816, Mrows, 1024, FF}; pg8::StaticOrder S; S.init(Mrows, 1024, G, bx);
            pg8::EpiRes E{step == 0 ? x : H, step == 0 ? ctx : H + (size_t)ML * DM, H, MODl + (sub ? 8 : 2) * DM, 0.5f, ALPHA};
            pg8::gemm_phase<pg8::EpiRes, pg8::StaticOrder, true, true>(lds, g, S, E);
        }
        xcd_barrier(xb);
        {
            const int lnidx = layer * 3 + (sub ? 2 : 0);
            const float* MODn = sub == 0 ? MODl : (layer == 0 ? MOD + (size_t)9 * NMOD : nullptr);
            ln_rows(H, Mrows, lng + lnidx * DM, lnb + lnidx * DM, step == 3 ? a.out : nullptr, MODn, sub == 0 ? 3 : 0, U, gw, NGW, lane);
        }
        if (step == 3) break;
        xcd_barrier(xb);
        if (sub == 0) {
            for (int rep = 0; rep < REP_QKV; ++rep) {
                const int Nq = layer == 0 ? 3072 : 1536;
                pg8::Gemm g{U, layer == 0 ? NAQKV : WAQKV, MT, Nq, 1024}; pg8::StaticOrder S; S.init(MT, Nq, G, bx);
                pg8::EpiQKV E{QKV, Nq, QSCALE, layer == 0 ? 0 : 1280, ROPE};
                pg8::gemm_phase<pg8::EpiQKV, pg8::StaticOrder, true, true>(lds, g, S, E);
            }
            xcd_barrier(xb);
            for (int rep = 0; rep < REP_ATT; ++rep) {
                LAS unsigned char* wlds = lds + wave * 8192;
                if (layer == 0) {
                    for (int bu = bx; bu < 1152; bu += G) {
                        if (bu < 1024) { const int b = bu & 7, rest = bu >> 3, h = rest >> 3, r = (rest & 7) * 4 + (wave >> 1), qt = wave & 1;
                            attn_wave_unit<0>(QKV, 3072, h * 64, 1024 + h * 64, 2048 + h * 64, b * SEQ + r * 64 + 32 * qt, b, r, qt, narpb + h * 465, ATTO, h * 64, wlds, lane); }
                        else { const int cu = bu - 1024, b = cu & 7, h = cu >> 3;
                            attn_wave_unit<2>(QKV, 3072, h * 64, 1024 + h * 64, 2048 + h * 64, ML + b * CTX + 32 * wave, b, 0, 0, nullptr, ATTO, h * 64, wlds, lane); }
                    }
                } else {
                    for (int bu = bx; bu < 1024; bu += G) { const int b = bu & 7, rest = bu >> 3, kvh = rest >> 5, qp = rest & 31, h = 4 * kvh + (wave & 3), qt = 2 * qp + (wave >> 2);
                        attn_wave_unit<1>(QKV, 1536, h * 64, 1024 + kvh * 64, 1280 + kvh * 64, b * SEQ + 32 * qt, b, 0, qt, wasink + h, ATTO, h * 64, wlds, lane); }
                }
            }
            xcd_barrier(xb);
            const int M2 = layer == 0 ? MT : ML;
            {
                pg8::Gemm g{ATTO, layer == 0 ? NAO : WAO, M2, 1024, 1024}; pg8::StaticOrder S; S.init(M2, 1024, G, bx);
                pg8::EpiRes E{H, H + (size_t)ML * DM, H, MODl + 5 * DM, 1.0f, ALPHA};
                pg8::gemm_phase<pg8::EpiRes, pg8::StaticOrder, true, true>(lds, g, S, E);
            }
            xcd_barrier(xb);
            ln_rows(H, M2, lng + (layer * 3 + 1) * DM, lnb + (layer * 3 + 1) * DM, nullptr, MODl, 6, U, gw, NGW, lane);
            xcd_barrier(xb);
        }
    }
}

extern "C" void kernel_launch(void* const* d_in, const int* in_sizes, int n_in, void* d_out, int out_size, void* d_ws, size_t ws_size, hipStream_t stream) {
    static int grid = 0;
    if (grid == 0) {
        if (n_in != 16 || ws_size < WS_END) { fprintf(stderr, "kernel_launch: expected 16 inputs and >= %zu bytes of workspace (got %d, %zu)\n", (size_t)WS_END, n_in, ws_size); grid = -1; return; }
        int dev = 0, cus = 0, per_cu = 0;
        hipGetDevice(&dev);
        hipDeviceGetAttribute(&cus, hipDeviceAttributeMultiprocessorCount, dev);
        if (hipFuncSetAttribute((const void*)fwd_megakernel, hipFuncAttributeMaxDynamicSharedMemorySize, LDS_BYTES) != hipSuccess) { fprintf(stderr, "kernel_launch: hipFuncSetAttribute failed\n"); grid = -1; return; }
        if (hipOccupancyMaxActiveBlocksPerMultiprocessor(&per_cu, (const void*)fwd_megakernel, NTHREADS, LDS_BYTES) != hipSuccess || per_cu < 1) { fprintf(stderr, "kernel_launch: occupancy query failed (%d)\n", per_cu); grid = -1; return; }
        grid = cus * per_cu;
    }
    if (grid < 0) return;
    Args a{};
    for (int i = 0; i < 16; ++i) a.in[i] = (const float*)d_in[i];
    a.out = (float*)d_out; a.ws = (unsigned char*)d_ws;
    void* args[] = {&a};
    hipError_t e = hipLaunchCooperativeKernel((const void*)fwd_megakernel, dim3(grid), dim3(NTHREADS), args, LDS_BYTES, stream);
    if (e != hipSuccess) fprintf(stderr, "kernel_launch: cooperative launch failed: %s (grid %d)\n", hipGetErrorString(e), grid);
}
```
